# Optimizing an MI355X kernel written in HIP

```python
import jax, jax.numpy as jnp
from jax import lax
import numpy as np

D_MODEL = 2048
BATCH = 1
SEQ = 8192
DEPTH = 1

HG_HEADS = 8
HG_HEAD_DIM = 128
HG_WIDTH = HG_HEADS * HG_HEAD_DIM
HG_CHUNK = 64
ATT_HEADS = 16
ATT_KV_HEADS = 4
ATT_HEAD_DIM = 64
ATT_GROUP = ATT_HEADS // ATT_KV_HEADS
ATT_WIDTH = ATT_HEADS * ATT_HEAD_DIM
KV_WIDTH = ATT_KV_HEADS * ATT_HEAD_DIM
WINDOW = 128
ATT_BLOCK = 128
ROPE_THETA = 10000.0
D_FF = 4 * D_MODEL
ALPHA = (2 * DEPTH) ** 0.25
BETA = (8 * DEPTH) ** -0.25
LN_EPS = 1e-5
RMS_EPS = 1e-6

SPLIT_SIZES = (HG_WIDTH, HG_WIDTH, HG_WIDTH, HG_WIDTH,
               ATT_WIDTH, KV_WIDTH, KV_WIDTH,
               D_MODEL, D_MODEL)
D_IN = sum(SPLIT_SIZES)

kernel_name = "hgrn2_swa_sink_gated_hybrid"


def _split_points():
    pts, acc = [], 0
    for s in SPLIT_SIZES[:-1]:
        acc += s
        pts.append(acc)
    return pts


def layer_norm(x, gain, bias):
    xf = x.astype(jnp.float32)
    mu = jnp.mean(xf, axis=-1, keepdims=True)
    var = jnp.mean(jnp.square(xf - mu), axis=-1, keepdims=True)
    y = (xf - mu) * lax.rsqrt(var + LN_EPS) * gain.astype(jnp.float32) + bias.astype(jnp.float32)
    return y.astype(x.dtype)


def hgrn2_mixer(q, f_logit, i, g, lb, norm_gain):
    B, S, _ = q.shape
    f32 = jnp.float32
    lb = lb.astype(f32)
    f = lb + (1.0 - lb) * jax.nn.sigmoid(f_logit.astype(f32))
    log_f = jnp.log(f)
    k = 1.0 - f
    qf = jax.nn.silu(q.astype(f32))
    nc = S // HG_CHUNK

    def to_chunks(t):
        return t.reshape(B, nc, HG_CHUNK, HG_HEADS, HG_HEAD_DIM).transpose(1, 0, 3, 2, 4)

    qc, kc, vc, lc = to_chunks(qf), to_chunks(k), to_chunks(i.astype(f32)), to_chunks(log_f)
    causal = jnp.tril(jnp.ones((HG_CHUNK, HG_CHUNK), dtype=bool))[:, :, None]

    def step(state, inp):
        q_, k_, v_, l_ = inp
        b = jnp.cumsum(l_, axis=2)
        o_inter = jnp.einsum('bhtk,bhkv->bhtv', q_ * jnp.exp(b), state)
        diff = b[:, :, :, None, :] - b[:, :, None, :, :]
        decay = jnp.exp(jnp.where(causal, diff, -jnp.inf))
        scores = jnp.einsum('bhtk,bhtsk,bhsk->bhts', q_, decay, k_)
        o = o_inter + jnp.einsum('bhts,bhsv->bhtv', scores, v_)
        b_last = b[:, :, -1:, :]
        k_dec = k_ * jnp.exp(b_last - b)
        state = jnp.exp(b_last[:, :, 0, :])[..., None] * state + jnp.einsum('bhsk,bhsv->bhkv', k_dec, v_)
        return state, o

    state0 = jnp.zeros((B, HG_HEADS, HG_HEAD_DIM, HG_HEAD_DIM), f32)
    _, oc = lax.scan(step, state0, (qc, kc, vc, lc))
    o = oc.transpose(1, 0, 3, 2, 4).reshape(B, S, HG_HEADS, HG_HEAD_DIM)
    o = o * lax.rsqrt(jnp.mean(jnp.square(o), axis=-1, keepdims=True) + RMS_EPS)
    o = o.reshape(B, S, HG_WIDTH) * norm_gain.astype(f32)
    o = o * jax.nn.silu(g.astype(f32))
    return o.astype(q.dtype)


def rope(t, pos):
    half = t.shape[-1] // 2
    inv = ROPE_THETA ** (-jnp.arange(half, dtype=jnp.float32) / half)
    ang = pos.astype(jnp.float32)[:, None] * inv[None, :]
    cos = jnp.cos(ang)[None, :, None, :]
    sin = jnp.sin(ang)[None, :, None, :]
    tf = t.astype(jnp.float32)
    t1, t2 = tf[..., :half], tf[..., half:]
    return jnp.concatenate([t1 * cos - t2 * sin, t2 * cos + t1 * sin], axis=-1).astype(t.dtype)


def swa_sink_attention(q, k, v, sinks):
    B, S = q.shape[:2]
    f32 = jnp.float32
    nb = S // ATT_BLOCK
    qb = q.reshape(B, nb, ATT_BLOCK, ATT_KV_HEADS, ATT_GROUP, ATT_HEAD_DIM).astype(f32)

    def with_prev(t):
        tb = t.reshape(B, nb, ATT_BLOCK, ATT_KV_HEADS, ATT_HEAD_DIM).astype(f32)
        prev = jnp.pad(tb, ((0, 0), (1, 0), (0, 0), (0, 0), (0, 0)))[:, :-1]
        return jnp.concatenate([prev, tb], axis=2)

    kb, vb = with_prev(k), with_prev(v)
    scale = ATT_HEAD_DIM ** -0.5
    scores = jnp.einsum('bnqkgd,bnskd->bnkgqs', qb, kb) * scale
    qi = jnp.arange(ATT_BLOCK)[:, None] + ATT_BLOCK
    si = jnp.arange(2 * ATT_BLOCK)[None, :]
    rel = qi - si
    band = (rel >= 0) & (rel < WINDOW)
    key_pos = jnp.arange(nb)[:, None] * ATT_BLOCK - ATT_BLOCK + si
    valid = band[None] & (key_pos >= 0)[:, None, :]
    scores = jnp.where(valid[None, :, None, None], scores, -jnp.inf)
    sink = sinks.astype(f32).reshape(ATT_KV_HEADS, ATT_GROUP)[None, None, :, :, None, None]
    m = jnp.maximum(jnp.max(scores, axis=-1, keepdims=True), sink)
    p = jnp.exp(scores - m)
    probs = p / (jnp.sum(p, axis=-1, keepdims=True) + jnp.exp(sink - m))
    out = jnp.einsum('bnkgqs,bnskd->bnqkgd', probs, vb)
    return out.reshape(B, S, ATT_WIDTH).astype(q.dtype)


def setup_inputs(seed: int = 0) -> dict:
    key = jax.random.key(seed)
    ks = jax.random.split(key, 16)
    f32 = jnp.float32
    x = jax.random.normal(ks[0], (BATCH, SEQ, D_MODEL), f32)
    w_in = jax.random.normal(ks[1], (DEPTH, D_MODEL, D_IN), f32) * D_MODEL ** -0.5
    hg_lb_logits = jax.random.normal(ks[2], (DEPTH + 1, HG_WIDTH), f32) * 0.5
    hg_norm_gain = 1.0 + 0.02 * jax.random.normal(ks[3], (DEPTH, HG_WIDTH), f32)
    attn_sinks = jax.random.normal(ks[4], (DEPTH, ATT_HEADS), f32)
    w_branch_a = jax.random.normal(ks[5], (DEPTH, HG_WIDTH, D_MODEL), f32) * (HG_WIDTH ** -0.5) * BETA
    w_branch_b = jax.random.normal(ks[6], (DEPTH, ATT_WIDTH, D_MODEL), f32) * (ATT_WIDTH ** -0.5) * BETA
    w_out = jax.random.normal(ks[7], (DEPTH, D_MODEL, D_MODEL), f32) * (D_MODEL ** -0.5) * BETA
    ln1_gain = 1.0 + 0.02 * jax.random.normal(ks[8], (DEPTH, D_MODEL), f32)
    ln1_bias = 0.02 * jax.random.normal(ks[9], (DEPTH, D_MODEL), f32)
    w_ff1 = jax.random.normal(ks[10], (DEPTH, D_MODEL, D_FF), f32) * (D_MODEL ** -0.5) * BETA
    w_ff2 = jax.random.normal(ks[11], (DEPTH, D_FF, D_MODEL), f32) * (D_FF ** -0.5) * BETA
    ln2_gain = 1.0 + 0.02 * jax.random.normal(ks[12], (DEPTH, D_MODEL), f32)
    ln2_bias = 0.02 * jax.random.normal(ks[13], (DEPTH, D_MODEL), f32)
    return {"x": x, "w_in": w_in, "hg_lb_logits": hg_lb_logits, "hg_norm_gain": hg_norm_gain,
            "attn_sinks": attn_sinks, "w_branch_a": w_branch_a, "w_branch_b": w_branch_b,
            "w_out": w_out, "ln1_gain": ln1_gain, "ln1_bias": ln1_bias, "w_ff1": w_ff1,
            "w_ff2": w_ff2, "ln2_gain": ln2_gain, "ln2_bias": ln2_bias}


def reference(x, w_in, hg_lb_logits, hg_norm_gain, attn_sinks, w_branch_a, w_branch_b,
              w_out, ln1_gain, ln1_bias, w_ff1, w_ff2, ln2_gain, ln2_bias):
    B, S, _ = x.shape
    pos = jnp.arange(S)
    lb_all = jnp.cumsum(jax.nn.softmax(hg_lb_logits.astype(jnp.float32), axis=0), axis=0)
    splits = _split_points()
    for l in range(DEPTH):
        proj = x @ w_in[l]
        hq, hf, hi, hg, aq, ak, av, ga, gb = jnp.split(proj, splits, axis=-1)
        y_a = hgrn2_mixer(hq, hf, hi, hg, lb_all[l], hg_norm_gain[l]) @ w_branch_a[l]
        q = rope(aq.reshape(B, S, ATT_HEADS, ATT_HEAD_DIM), pos)
        k = rope(ak.reshape(B, S, ATT_KV_HEADS, ATT_HEAD_DIM), pos)
        v = av.reshape(B, S, ATT_KV_HEADS, ATT_HEAD_DIM)
        y_b = swa_sink_attention(q, k, v, attn_sinks[l]) @ w_branch_b[l]
        mixed = jax.nn.sigmoid(ga) * y_a + jax.nn.sigmoid(gb) * y_b
        x = layer_norm(ALPHA * x + mixed @ w_out[l], ln1_gain[l], ln1_bias[l])
        h = jnp.square(jax.nn.relu(x @ w_ff1[l])) @ w_ff2[l]
        x = layer_norm(ALPHA * x + h, ln2_gain[l], ln2_bias[l])
    return x
```

```cpp
#include <hip/hip_runtime.h>
#include <hip/hip_cooperative_groups.h>
#include <cstdio>
#include <cstdint>
namespace cg = cooperative_groups;

constexpr int SEQ = 8192, DM = 2048, DIN = 9728, DFF = 8192;
constexpr float ALPHA = 1.189207115002721f;
constexpr float LOG2E = 1.4426950408889634f;
constexpr size_t MiB = 1ull << 20;
constexpr size_t WS_CTL = 0, WS_ROPE = 1 * MiB, WS_DTOT = 3 * MiB;
constexpr size_t WS_WIN = 4 * MiB, WS_XB = 42 * MiB;
constexpr size_t WS_WAB = 4 * MiB, WS_WOUT = 12 * MiB;
constexpr size_t WS_L = 20 * MiB, WS_SINIT = 36 * MiB;
constexpr size_t WS_W1 = 20 * MiB, WS_W2 = 52 * MiB;
constexpr size_t WS_SGA = 84 * MiB, WS_X1B = 84 * MiB;
constexpr size_t WS_SGB = 116 * MiB, WS_OAB = 148 * MiB, WS_LF = 180 * MiB, WS_AQ = 212 * MiB;
constexpr size_t WS_H1 = 116 * MiB;
constexpr size_t WS_QH = 244 * MiB, WS_HV = 260 * MiB, WS_MIX = 244 * MiB, WS_GS = 276 * MiB, WS_AK = 292 * MiB, WS_AV = 296 * MiB;
constexpr size_t WS_END = 300 * MiB;
namespace pg8 {
#define PG8_LAS __attribute__((address_space(3)))
typedef unsigned short bf16_t;
typedef short bf16x8 __attribute__((ext_vector_type(8)));
typedef float f32x4 __attribute__((ext_vector_type(4)));
typedef unsigned u32x4 __attribute__((ext_vector_type(4)));
typedef unsigned u32x2 __attribute__((ext_vector_type(2)));
constexpr int BM = 256, BK = 64, HALF = 128, HTB = HALF * BK * 2  , STAGE_BYTES = 8 * HTB, NXCD = 8, WGM = 8;

__host__ __device__ __forceinline__ int lds_byte(int r, int c) { const int st = (r >> 4) * 2 + (c >> 5), rr = r & 15, cc = c & 31, ob = rr * 64 + cc * 2; return st * 1024 + (ob ^ (((ob >> 9) & 1) << 5)); }
__host__ __device__ __forceinline__ void stage_rc(int b, int& R, int& C) { const int st = b / 1024, sb = b % 1024, swz = sb ^ (((sb >> 9) & 1) << 5); R = (st >> 1) * 16 + swz / 64; C = (st & 1) * 32 + (swz % 64) / 2; }
__host__ __device__ __forceinline__ int perm32(int rho) { const int n = rho >> 4, i = rho & 15; return 8 * (i >> 2) + 4 * n + (i & 3); }

struct Unit { int pm, pn; };
struct Gemm { const bf16_t* A; const bf16_t* Bt; int M, N, K; };

struct StaticOrder {
    int nM, nN, nwg, G, c;
    __host__ __device__ void init(int M, int N, int G_, int c_) { nM = M / BM; nN = N / BM; nwg = nM * nN; G = G_; c = c_; }
    __host__ __device__ bool next(int i, Unit& u) const {
        const long L = (long)i * G + c; if (L >= nwg) return false;
        int wgid = (int)L; { const int q = nwg / NXCD, r = nwg % NXCD, xcd = wgid % NXCD, off = wgid / NXCD; wgid = (xcd < r ? xcd * (q + 1) : r * (q + 1) + (xcd - r) * q) + off; }
        const int nig = WGM * nN, gid = wgid / nig, fm = gid * WGM, gsz = (nM - fm) < WGM ? (nM - fm) : WGM;
        u.pm = fm + ((wgid % nig) % gsz); u.pn = (wgid % nig) / gsz; return true;
    }
    __device__ __forceinline__ void a_ready(const Unit&) const {}
    __device__ __forceinline__ void done(const Unit&) const {}
};

__device__ __forceinline__ unsigned cvt_pk_bf16(float lo, float hi) { unsigned r; asm volatile("v_cvt_pk_bf16_f32 %0, %1, %2" : "=v"(r) : "v"(lo), "v"(hi)); return r; }
__device__ __forceinline__ float bflo(unsigned w) { return __uint_as_float(w << 16); }
__device__ __forceinline__ float bfhi(unsigned w) { return __uint_as_float(w & 0xffff0000u); }
__device__ __forceinline__ float fsigm(float v) { return __builtin_amdgcn_rcpf(1.0f + __expf(-v)); }
enum { OP_NONE = 0, OP_SILU = 1, OP_SIGM = 2, OP_RELU2 = 3, OP_GATE = 4, OP_LF = 5, OP_ROPE = 6, OP_RES = 7 };
struct Epi {
    static constexpr bool PERM = true, AFTER_DRAIN = false;
    int mode; unsigned char* ws; const float* x; const float* lbl; float* out;
    __device__ __forceinline__ void mid(f32x4 (&acc)[2][2][4][2], const Unit& u, int wr, int wc, int fr, int fq) const {
        const bf16_t* ga = (const bf16_t*)(ws + WS_SGA); const bf16_t* gb = (const bf16_t*)(ws + WS_SGB);
        int row0 = u.pm * BM + wr * 64 + fr, col0 = u.pn * BM + wc * 32 + 8 * fq;
        asm volatile("" : "+v"(row0), "+v"(col0));
#pragma unroll
        for (int ai = 0; ai < 2; ++ai)
#pragma unroll
            for (int m = 0; m < 4; ++m)
#pragma unroll
                for (int bj = 0; bj < 2; ++bj) {
                    const size_t off = (size_t)(row0 + ai * HALF + m * 16) * 2048 + col0 + bj * HALF;
                    const u32x4 a = *(const u32x4*)(ga + off), b = *(const u32x4*)(gb + off);
                    f32x4 r0, r1;
                    r0[0] = bflo(a.x) * __builtin_amdgcn_rcpf(bflo(b.x)); r0[1] = bfhi(a.x) * __builtin_amdgcn_rcpf(bfhi(b.x));
                    r0[2] = bflo(a.y) * __builtin_amdgcn_rcpf(bflo(b.y)); r0[3] = bfhi(a.y) * __builtin_amdgcn_rcpf(bfhi(b.y));
                    r1[0] = bflo(a.z) * __builtin_amdgcn_rcpf(bflo(b.z)); r1[1] = bfhi(a.z) * __builtin_amdgcn_rcpf(bfhi(b.z));
                    r1[2] = bflo(a.w) * __builtin_amdgcn_rcpf(bflo(b.w)); r1[3] = bfhi(a.w) * __builtin_amdgcn_rcpf(bfhi(b.w));
                    acc[ai][bj][m][0] *= r0; acc[ai][bj][m][1] *= r1;
                    asm volatile("" : "+v"(acc[ai][bj][m][0]), "+v"(acc[ai][bj][m][1]) :: "memory");
                }
    }
    __device__ __forceinline__ void operator()(const f32x4 (&acc)[2][2][4][2], const Unit& u, int wr, int wc, int fr, int fq) const {
        const int row0 = u.pm * BM + wr * 64 + fr, ct0 = wc * 32 + 8 * fq, pn = u.pn;
        int op; bf16_t* dst = nullptr; int ld = 0, cb = 0; float rs = 1.0f;
        if (mode == 0) {
            if (pn < 4)        { op = OP_SILU; dst = (bf16_t*)(ws + WS_QH); ld = 1024; cb = pn * 256; }
            else if (pn < 8)   { op = OP_LF; cb = (pn - 4) * 256; }
            else if (pn < 12)  { op = OP_NONE; dst = (bf16_t*)(ws + WS_HV); ld = 1024; cb = (pn - 8) * 256; }
            else if (pn < 16)  { op = OP_SILU; dst = (bf16_t*)(ws + WS_GS); ld = 1024; cb = (pn - 12) * 256; }
            else if (pn < 20)  { op = OP_ROPE; dst = (bf16_t*)(ws + WS_AQ); ld = 1024; cb = (pn - 16) * 256; rs = 0.125f * LOG2E; }
            else if (pn == 20) { op = OP_ROPE; dst = (bf16_t*)(ws + WS_AK); ld = 256; cb = 0; }
            else if (pn == 21) { op = OP_NONE; dst = (bf16_t*)(ws + WS_AV); ld = 256; cb = 0; }
            else if (pn < 30)  { op = OP_SIGM; dst = (bf16_t*)(ws + WS_SGA); ld = 2048; cb = (pn - 22) * 256; }
            else               { op = OP_SIGM; dst = (bf16_t*)(ws + WS_SGB); ld = 2048; cb = (pn - 30) * 256; }
        } else if (mode == 1)  { op = OP_GATE; dst = (bf16_t*)(ws + WS_MIX); ld = 2048; cb = pn * 256; }
        else if (mode == 3)    { op = OP_RELU2; dst = (bf16_t*)(ws + WS_H1); ld = 8192; cb = pn * 256; }
        else op = OP_RES;
        if (op <= OP_GATE) {
            const bf16_t* gb = (const bf16_t*)(ws + WS_SGB);
#pragma unroll
            for (int ai = 0; ai < 2; ++ai)
#pragma unroll
                for (int m = 0; m < 4; ++m) { const int row = row0 + ai * HALF + m * 16;
#pragma unroll
                    for (int bj = 0; bj < 2; ++bj) { f32x4 v0 = acc[ai][bj][m][0], v1 = acc[ai][bj][m][1]; const int c = cb + ct0 + bj * HALF;
                        if (op == OP_SILU) {
#pragma unroll
                            for (int e = 0; e < 4; ++e) { v0[e] *= fsigm(v0[e]); v1[e] *= fsigm(v1[e]); }
                        } else if (op == OP_SIGM) {
#pragma unroll
                            for (int e = 0; e < 4; ++e) { v0[e] = fsigm(v0[e]); v1[e] = fsigm(v1[e]); }
                        } else if (op == OP_RELU2) {
#pragma unroll
                            for (int e = 0; e < 4; ++e) { const float a = fmaxf(v0[e], 0.f), b = fmaxf(v1[e], 0.f); v0[e] = a * a; v1[e] = b * b; }
                        } else if (op == OP_GATE) {
                            const u32x4 g = *(const u32x4*)(gb + (size_t)row * 2048 + c);
                            v0[0] *= bflo(g.x); v0[1] *= bfhi(g.x); v0[2] *= bflo(g.y); v0[3] *= bfhi(g.y);
                            v1[0] *= bflo(g.z); v1[1] *= bfhi(g.z); v1[2] *= bflo(g.w); v1[3] *= bfhi(g.w);
                        }
                        u32x4 w; w.x = cvt_pk_bf16(v0[0], v0[1]); w.y = cvt_pk_bf16(v0[2], v0[3]); w.z = cvt_pk_bf16(v1[0], v1[1]); w.w = cvt_pk_bf16(v1[2], v1[3]);
                        *(u32x4*)(dst + (size_t)row * ld + c) = w; } }
        } else if (op == OP_LF) {
            float* lf = (float*)(ws + WS_LF);
#pragma unroll
            for (int bj = 0; bj < 2; ++bj) { const int c = cb + ct0 + bj * HALF;
                const f32x4 a0 = *(const f32x4*)(lbl + c), a1 = *(const f32x4*)(lbl + c + 4), b0 = *(const f32x4*)(lbl + 1024 + c), b1 = *(const f32x4*)(lbl + 1024 + c + 4);
                f32x4 lb0, lb1;
#pragma unroll
                for (int e = 0; e < 4; ++e) { lb0[e] = fsigm(a0[e] - b0[e]); lb1[e] = fsigm(a1[e] - b1[e]); }
#pragma unroll
                for (int ai = 0; ai < 2; ++ai)
#pragma unroll
                    for (int m = 0; m < 4; ++m) { const int row = row0 + ai * HALF + m * 16; f32x4 v0 = acc[ai][bj][m][0], v1 = acc[ai][bj][m][1];
#pragma unroll
                        for (int e = 0; e < 4; ++e) { v0[e] = __logf(lb0[e] + (1.0f - lb0[e]) * fsigm(v0[e])); v1[e] = __logf(lb1[e] + (1.0f - lb1[e]) * fsigm(v1[e])); }
                        *(f32x4*)(lf + (size_t)row * 1024 + c) = v0; *(f32x4*)(lf + (size_t)row * 1024 + c + 4) = v1; } }
        } else if (op == OP_ROPE) {
            const float* rope = (const float*)(ws + WS_ROPE); const int i0 = 16 * (wc & 1) + 4 * fq;
#pragma unroll
            for (int ai = 0; ai < 2; ++ai)
#pragma unroll
                for (int m = 0; m < 4; ++m) { const int row = row0 + ai * HALF + m * 16;
                    const f32x4 cs = *(const f32x4*)(rope + (size_t)row * 64 + i0), sn = *(const f32x4*)(rope + (size_t)row * 64 + 32 + i0);
#pragma unroll
                    for (int bj = 0; bj < 2; ++bj) { const f32x4 t1 = acc[ai][bj][m][0], t2 = acc[ai][bj][m][1];
                        const f32x4 o1 = (t1 * cs - t2 * sn) * rs, o2 = (t2 * cs + t1 * sn) * rs;
                        const int hc = cb + bj * HALF + (wc >> 1) * 64 + i0;
                        u32x2 w1, w2; w1.x = cvt_pk_bf16(o1[0], o1[1]); w1.y = cvt_pk_bf16(o1[2], o1[3]); w2.x = cvt_pk_bf16(o2[0], o2[1]); w2.y = cvt_pk_bf16(o2[2], o2[3]);
                        *(u32x2*)(dst + (size_t)row * ld + hc) = w1; *(u32x2*)(dst + (size_t)row * ld + hc + 32) = w2; } }
        } else {
            const float* src = (mode == 2) ? x : out;
#pragma unroll
            for (int ai = 0; ai < 2; ++ai)
#pragma unroll
                for (int m = 0; m < 4; ++m) { const int row = row0 + ai * HALF + m * 16;
#pragma unroll
                    for (int bj = 0; bj < 2; ++bj) { const size_t off = (size_t)row * DM + pn * 256 + ct0 + bj * HALF;
                        const f32x4 s0 = *(const f32x4*)(src + off), s1 = *(const f32x4*)(src + off + 4);
                        *(f32x4*)(out + off) = s0 * ALPHA + acc[ai][bj][m][0]; *(f32x4*)(out + off + 4) = s1 * ALPHA + acc[ai][bj][m][1]; } }
        }
    }
};
template <class Epi, class Sched, bool ALIGN_EPI = false, bool SP2 = false>
__device__ __forceinline__ void gemm_phase(PG8_LAS unsigned char* lds, const Gemm g, const Sched& S, const Epi& E) {
    const int tid = threadIdx.x, wid = __builtin_amdgcn_readfirstlane(tid >> 6), lane = tid & 63, wr = wid >> 2, wc = wid & 3, fr = lane & 15, fq = lane >> 4;
    const int K = g.K, nt = K / BK;
    unsigned voffA[2], voffB[2];
#pragma unroll
    for (int i = 0; i < 2; ++i) { int R, C; stage_rc(tid * 16 + i * 8192, R, C); const int Rb = Epi::PERM ? ((R & ~31) + perm32(R & 31)) : R;
        voffA[i] = (unsigned)(R * K + C) * 2u; voffB[i] = (unsigned)(Rb * K + C) * 2u; }
    const size_t kstep = (size_t)(BK * 2);
    const size_t hstep = (size_t)HALF * K * 2;
    const size_t tstep = 2 * hstep;
    const unsigned ldsw = (unsigned)wid * 1024u;
    const int aoff = lds_byte(wr * 64 + fr, fq * 8), boff = lds_byte(wc * 32 + fr, fq * 8);
#define PG8_SA(b, h) (((b) * 2 + (h)) * HTB)
#define PG8_SB(b, h) ((4 + (b) * 2 + (h)) * HTB)
#define PG8_STAGE(bufoff, gbase, voff) do { _Pragma("unroll") for (int _i = 0; _i < 2; ++_i) \
        __builtin_amdgcn_global_load_lds((const unsigned*)((const char*)(gbase) + (voff)[_i]), (PG8_LAS unsigned*)(lds + (bufoff) + ldsw + _i * 8192), 16, 0, 0); } while (0)
#define PG8_LDA(dst, b, h) do { _Pragma("unroll") for (int m = 0; m < 4; ++m) _Pragma("unroll") for (int k = 0; k < 2; ++k) dst[m][k] = *(const PG8_LAS bf16x8*)(lds + PG8_SA(b, h) + aoff + m * 2048 + k * 1024); } while (0)
#define PG8_LDB(dst, b, h) do { _Pragma("unroll") for (int n = 0; n < 2; ++n) _Pragma("unroll") for (int k = 0; k < 2; ++k) dst[n][k] = *(const PG8_LAS bf16x8*)(lds + PG8_SB(b, h) + boff + n * 2048 + k * 1024); } while (0)
#define PG8_MMA(ai, bj, At, Bt) do { __builtin_amdgcn_s_setprio(1); _Pragma("unroll") for (int m = 0; m < 4; ++m) _Pragma("unroll") for (int n = 0; n < 2; ++n) _Pragma("unroll") for (int k = 0; k < 2; ++k) \
        acc[ai][bj][m][n] = __builtin_amdgcn_mfma_f32_16x16x32_bf16(Bt[n][k], At[m][k], acc[ai][bj][m][n], 0, 0, 0); __builtin_amdgcn_s_setprio(0); } while (0)
#define PG8_WAIT_V(n) asm volatile("s_waitcnt vmcnt(" #n ")" ::: "memory")
#define PG8_WAIT_L(n) asm volatile("s_waitcnt lgkmcnt(" #n ")" ::: "memory")
#define PG8_BAR __builtin_amdgcn_s_barrier()
#define PG8_SCHED __builtin_amdgcn_sched_barrier(0)
    Unit cur, nxt; int ui = 0;
    if (!S.next(0, cur)) return;
    f32x4 acc[2][2][4][2];
#pragma unroll
    for (int a = 0; a < 2; ++a)
#pragma unroll
        for (int b = 0; b < 2; ++b)
#pragma unroll
            for (int m = 0; m < 4; ++m)
#pragma unroll
                for (int n = 0; n < 2; ++n) acc[a][b][m][n] = (f32x4){0.f, 0.f, 0.f, 0.f};
    bf16x8 At[4][2], B0[2][2], B1[2][2];
    const char* cA = (const char*)g.A + (size_t)cur.pm * tstep; const char* cB = (const char*)g.Bt + (size_t)cur.pn * tstep;
    S.a_ready(cur);
    if constexpr (SP2) {
        PG8_STAGE(PG8_SB(0, 0), cB, voffB); PG8_STAGE(PG8_SB(0, 1), cB + hstep, voffB); PG8_STAGE(PG8_SA(0, 0), cA, voffA); PG8_STAGE(PG8_SA(0, 1), cA + hstep, voffA);
        if (wr == 1) PG8_BAR;
        PG8_WAIT_V(2); PG8_BAR;
        PG8_STAGE(PG8_SB(1, 0), cB + kstep, voffB); PG8_STAGE(PG8_SA(1, 0), cA + kstep, voffA); PG8_STAGE(PG8_SB(1, 1), cB + hstep + kstep, voffB);
        PG8_WAIT_V(6); PG8_BAR;
    } else {
        PG8_STAGE(PG8_SB(0, 0), cB, voffB); PG8_STAGE(PG8_SA(0, 0), cA, voffA); PG8_STAGE(PG8_SB(0, 1), cB + hstep, voffB); PG8_STAGE(PG8_SA(0, 1), cA + hstep, voffA);
        if (wr == 1) PG8_BAR;
        PG8_WAIT_V(4); PG8_BAR;
        PG8_STAGE(PG8_SB(1, 0), cB + kstep, voffB); PG8_STAGE(PG8_SA(1, 0), cA + kstep, voffA); PG8_STAGE(PG8_SB(1, 1), cB + hstep + kstep, voffB);
        PG8_WAIT_V(6); PG8_BAR;
    }
    for (;;) {
        const bool has_next = S.next(ui + 1, nxt);
        const char* nA = has_next ? (const char*)g.A + (size_t)nxt.pm * tstep : cA; const char* nB = has_next ? (const char*)g.Bt + (size_t)nxt.pn * tstep : cB;
        for (int t = 0; t < nt; t += 2) {
            if (E.mode == 1 && t == (nt >> 1)) E.mid(acc, cur, wr, wc, fr, fq);
            const bool last = (t == nt - 2);
            const char* a1 = cA + (size_t)(t + 1) * kstep;
            const char* a2 = last ? nA : cA + (size_t)(t + 2) * kstep; const char* b2 = last ? nB : cB + (size_t)(t + 2) * kstep;
            const char* a3 = a2 + kstep; const char* b3 = b2 + kstep;
            if (last && has_next) S.a_ready(nxt);
            if constexpr (SP2) {
            PG8_LDB(B0, 0, 0); PG8_LDB(B1, 0, 1); PG8_SCHED; PG8_LDA(At, 0, 0); PG8_STAGE(PG8_SA(1, 1), a1 + hstep, voffA);
            PG8_WAIT_V(8); PG8_WAIT_L(0); PG8_BAR; PG8_MMA(0, 0, At, B0); PG8_MMA(0, 1, At, B1); PG8_BAR; PG8_SCHED;
            PG8_LDA(At, 0, 1); PG8_STAGE(PG8_SB(0, 0), b2, voffB); PG8_STAGE(PG8_SB(0, 1), b2 + hstep, voffB); PG8_STAGE(PG8_SA(0, 0), a2, voffA);
            PG8_WAIT_V(8); PG8_WAIT_L(0); PG8_BAR; PG8_MMA(1, 0, At, B0); PG8_MMA(1, 1, At, B1); PG8_BAR; PG8_SCHED;
            PG8_LDB(B0, 1, 0); PG8_LDB(B1, 1, 1); PG8_SCHED; PG8_LDA(At, 1, 0); PG8_STAGE(PG8_SA(0, 1), a2 + hstep, voffA);
            PG8_WAIT_V(8); PG8_WAIT_L(0); PG8_BAR; PG8_MMA(0, 0, At, B0); PG8_MMA(0, 1, At, B1); PG8_BAR; PG8_SCHED;
            PG8_LDA(At, 1, 1); PG8_STAGE(PG8_SB(1, 0), b3, voffB); PG8_STAGE(PG8_SB(1, 1), b3 + hstep, voffB); PG8_STAGE(PG8_SA(1, 0), a3, voffA);
            PG8_WAIT_V(8); PG8_WAIT_L(0); PG8_BAR; PG8_MMA(1, 0, At, B0); PG8_MMA(1, 1, At, B1); PG8_BAR; PG8_SCHED;
            } else {
            PG8_LDB(B0, 0, 0); PG8_SCHED; PG8_LDA(At, 0, 0); PG8_STAGE(PG8_SA(1, 1), a1 + hstep, voffA);
            PG8_WAIT_L(8); PG8_BAR; PG8_WAIT_L(0); PG8_MMA(0, 0, At, B0); PG8_BAR; PG8_SCHED;
            PG8_LDB(B1, 0, 1); PG8_STAGE(PG8_SB(0, 0), b2, voffB);
            PG8_BAR; PG8_WAIT_L(0); PG8_MMA(0, 1, At, B1); PG8_BAR;
            PG8_LDA(At, 0, 1); PG8_STAGE(PG8_SA(0, 0), a2, voffA);
            PG8_BAR; PG8_WAIT_L(0); PG8_MMA(1, 0, At, B0); PG8_BAR; PG8_SCHED;
            PG8_STAGE(PG8_SB(0, 1), b2 + hstep, voffB);
            PG8_WAIT_V(6); PG8_BAR; PG8_MMA(1, 1, At, B1); PG8_BAR;
            PG8_LDB(B0, 1, 0); PG8_SCHED; PG8_LDA(At, 1, 0); PG8_STAGE(PG8_SA(0, 1), a2 + hstep, voffA);
            PG8_WAIT_L(8); PG8_BAR; PG8_WAIT_L(0); PG8_MMA(0, 0, At, B0); PG8_BAR; PG8_SCHED;
            PG8_LDB(B1, 1, 1); PG8_STAGE(PG8_SB(1, 0), b3, voffB);
            PG8_BAR; PG8_WAIT_L(0); PG8_MMA(0, 1, At, B1); PG8_BAR;
            PG8_LDA(At, 1, 1); PG8_STAGE(PG8_SA(1, 0), a3, voffA);
            PG8_BAR; PG8_WAIT_L(0); PG8_MMA(1, 0, At, B0); PG8_BAR; PG8_SCHED;
            PG8_STAGE(PG8_SB(1, 1), b3 + hstep, voffB);
            PG8_WAIT_V(6); PG8_BAR; PG8_MMA(1, 1, At, B1); PG8_BAR;
            }
        }
        if constexpr (ALIGN_EPI) { if (wr == 0) PG8_BAR; }
        if constexpr (!Epi::AFTER_DRAIN) { E(acc, cur, wr, wc, fr, fq); S.done(cur); }
        if (!has_next) break;
#pragma unroll
        for (int a = 0; a < 2; ++a)
#pragma unroll
            for (int b = 0; b < 2; ++b)
#pragma unroll
                for (int m = 0; m < 4; ++m)
#pragma unroll
                    for (int n = 0; n < 2; ++n) acc[a][b][m][n] = (f32x4){0.f, 0.f, 0.f, 0.f};
        cur = nxt; cA = nA; cB = nB; ++ui;
        if constexpr (ALIGN_EPI) { if (wr == 1) PG8_BAR; }
    }
    PG8_WAIT_V(0);
    if constexpr (!ALIGN_EPI) { if (wr == 0) PG8_BAR; }
    PG8_BAR;
    if constexpr (Epi::AFTER_DRAIN) { E.fused(acc, cur, wr, wc, fr, fq, lds, wid, lane); S.done(cur); }
#undef PG8_SA
#undef PG8_SB
#undef PG8_STAGE
#undef PG8_LDA
#undef PG8_LDB
#undef PG8_MMA
#undef PG8_WAIT_V
#undef PG8_WAIT_L
#undef PG8_BAR
#undef PG8_SCHED
}
}

#define LAS __attribute__((address_space(3)))
typedef unsigned short bf16;
typedef unsigned v4u __attribute__((ext_vector_type(4)));
typedef unsigned v2u __attribute__((ext_vector_type(2)));
typedef float f32x4 __attribute__((ext_vector_type(4)));
typedef float f32x16 __attribute__((ext_vector_type(16)));
typedef short s16x4 __attribute__((ext_vector_type(4)));
typedef short s16x8 __attribute__((ext_vector_type(8)));
constexpr int NWAVES = 8, NTHR = 512;
constexpr int RING_BYTES = 131072, LDS_BYTES = 147456;
#define LDS_WAIT() asm volatile("s_waitcnt lgkmcnt(0)" ::: "memory")
__device__ __forceinline__ unsigned f2bf(float f) { unsigned u = __builtin_bit_cast(unsigned, f); return (u + 0x7fffu + ((u >> 16) & 1u)) >> 16; }
__device__ __forceinline__ unsigned pk2(float lo, float hi) { return f2bf(lo) | (f2bf(hi) << 16); }
__device__ __forceinline__ float bf2f(unsigned short h) { return __uint_as_float((unsigned)h << 16); }

struct Frame { LAS unsigned char* lds; int tid, lane, wave, G, vcu; unsigned char* ws; };

__device__ __forceinline__ int rope_rowmap(int n) {
    if (n < 4096 || n >= 5376) return n;
    const int d = n & 63, nn = d >> 5, w = (d >> 4) & 1, fq = (d >> 2) & 3, j = d & 3;
    return (n & ~63) + 32 * w + 8 * fq + 4 * nn + j;
}
__device__ __forceinline__ void transpose_item(const float* W, int N, bf16* WT, int ldd, int koff, bool rmap, LAS float* scr, int item, int lane) {
    const int nblk = N / 32, kb = item / nblk, nb = item % nblk, k0 = 64 * kb, n0 = 32 * nb;
#pragma unroll 8
    for (int i = 0; i < 32; ++i) { const int kk = 2 * i + (lane >> 5); scr[kk * 33 + (lane & 31)] = W[(size_t)(k0 + kk) * N + n0 + (lane & 31)]; }
    LDS_WAIT(); asm volatile("" ::: "memory");
    const int c = lane & 7;
#pragma unroll
    for (int j = 0; j < 4; ++j) { const int n = (lane >> 3) + 8 * j; const LAS float* s = scr + (8 * c) * 33 + n;
        v4u o; o.x = pk2(s[0 * 33], s[1 * 33]); o.y = pk2(s[2 * 33], s[3 * 33]); o.z = pk2(s[4 * 33], s[5 * 33]); o.w = pk2(s[6 * 33], s[7 * 33]);
        const int drow = rmap ? rope_rowmap(n0 + n) : (n0 + n);
        *(v4u*)(WT + (size_t)drow * ldd + koff + k0 + 8 * c) = o; }
    LDS_WAIT(); asm volatile("" ::: "memory");
}
__device__ __forceinline__ void transpose_weight(Frame& F, const float* W, int K, int N, bf16* WT, int ldd, int koff, bool rmap) {
    LAS float* scr = (LAS float*)(F.lds + F.wave * 16384);
    const int gw = F.vcu * NWAVES + F.wave, NGW = F.G * NWAVES, nitems = (K / 64) * (N / 32);
    for (int it = gw; it < nitems; it += NGW) transpose_item(W, N, WT, ldd, koff, rmap, scr, it, F.lane);
}
__device__ __forceinline__ float wave_sum(float v) {
#pragma unroll
    for (int o = 1; o < 64; o <<= 1) v += __shfl_xor(v, o);
    return v;
}
__device__ __forceinline__ void ln_phase(Frame& F, float* io, const float* gain, const float* bias, bf16* xb) {
    const int gw = F.vcu * NWAVES + F.wave, NGW = F.G * NWAVES;
    for (int r = gw; r < SEQ; r += NGW) {
        f32x4* p = (f32x4*)(io + (size_t)r * DM) + F.lane;
        f32x4 v[8]; float s = 0.f;
#pragma unroll
        for (int j = 0; j < 8; ++j) { v[j] = p[64 * j]; s += (v[j].x + v[j].y) + (v[j].z + v[j].w); }
        const float mean = wave_sum(s) * (1.f / DM); float s2 = 0.f;
#pragma unroll
        for (int j = 0; j < 8; ++j) { v[j] = v[j] - mean; s2 += (v[j].x * v[j].x + v[j].y * v[j].y) + (v[j].z * v[j].z + v[j].w * v[j].w); }
        const float rstd = 1.f / sqrtf(wave_sum(s2) * (1.f / DM) + 1e-5f);
#pragma unroll
        for (int j = 0; j < 8; ++j) { const f32x4 g = ((const f32x4*)gain)[64 * j + F.lane], b = ((const f32x4*)bias)[64 * j + F.lane];
            const f32x4 o = v[j] * rstd * g + b; p[64 * j] = o;
            if (xb) { v2u w; w.x = pk2(o.x, o.y); w.y = pk2(o.z, o.w); ((v2u*)(xb + (size_t)r * DM))[64 * j + F.lane] = w; } }
    }
}

constexpr int HL_QT = 0, HL_KT = 17408, HL_KH = 34816, HL_DV = 51200, HL_VT = 53248, HL_OS = 70656, HL_RED = 104448;
template <bool OUT> __device__ __forceinline__ void hgrn_unit(Frame& F, int u, const float* gain) {
    const int j = u >> 3, h = u & 7, tid = F.tid, lane = F.lane, w = F.wave, I = tid >> 7, k = tid & 127, dvl = lane & 15, q4 = lane >> 4;
    const float* lf = (const float*)(F.ws + WS_LF); const bf16* qh = (const bf16*)(F.ws + WS_QH); const bf16* hv = (const bf16*)(F.ws + WS_HV); const bf16* gs = (const bf16*)(F.ws + WS_GS);
    bf16* oab = (bf16*)(F.ws + WS_OAB);
    LAS bf16* Qt = (LAS bf16*)(F.lds + HL_QT); LAS bf16* Kt = (LAS bf16*)(F.lds + HL_KT); LAS bf16* KH = (LAS bf16*)(F.lds + HL_KH);
    LAS float* DV = (LAS float*)(F.lds + HL_DV); LAS bf16* VT = (LAS bf16*)(F.lds + HL_VT); LAS float* OS = (LAS float*)(F.lds + HL_OS); LAS float* RED = (LAS float*)(F.lds + HL_RED);
    f32x4 S[8];
    if (OUT) { const f32x4* sp = (const f32x4*)(F.ws + WS_SINIT) + (size_t)u * 4096 + w * 512 + lane;
#pragma unroll
        for (int j8 = 0; j8 < 8; ++j8) S[j8] = sp[j8 * 64]; }
    else {
#pragma unroll
        for (int j8 = 0; j8 < 8; ++j8) S[j8] = (f32x4){0.f, 0.f, 0.f, 0.f}; }
    float btot = 0.f;
    for (int ms = 0; ms < 4; ++ms) {
        const int t0 = 256 * j + 64 * ms;
        {
            const float* lfp = lf + (size_t)(t0 + 16 * I) * 1024 + h * 128 + k;
            float lv[16], b[16], kk[16];
#pragma unroll
            for (int i = 0; i < 16; ++i) lv[i] = lfp[(size_t)i * 1024];
            float qv[16];
            if (OUT) { const bf16* qp = qh + (size_t)(t0 + 16 * I) * 1024 + h * 128 + k;
#pragma unroll
                for (int i = 0; i < 16; ++i) qv[i] = bf2f(qp[(size_t)i * 1024]); }
            float run = 0.f;
#pragma unroll
            for (int i = 0; i < 16; ++i) { kk[i] = 1.0f - __expf(lv[i]); run += lv[i]; b[i] = run; }
            btot += run;
            unsigned pw[8];
#pragma unroll
            for (int i = 0; i < 8; ++i) pw[i] = pk2(kk[2 * i] * __expf(run - b[2 * i]), kk[2 * i + 1] * __expf(run - b[2 * i + 1]));
            LAS v4u* khp = (LAS v4u*)(KH + (I * 128 + k) * 16);
            khp[0] = (v4u){pw[0], pw[1], pw[2], pw[3]}; khp[1] = (v4u){pw[4], pw[5], pw[6], pw[7]};
            DV[I * 128 + k] = __expf(run);
            if (OUT) {
#pragma unroll
                for (int i = 0; i < 16; ++i) { Qt[(16 * I + i) * 136 + k] = (bf16)f2bf(qv[i] * __expf(b[i])); Kt[(16 * I + i) * 136 + k] = (bf16)f2bf(kk[i] * __expf(fminf(-b[i], 80.f))); } }
#pragma unroll
            for (int c = 0; c < 2; ++c) { const int ch = tid + 512 * c, tok = ch >> 4, dv0 = (ch & 15) * 8;
                const v4u vv = *(const v4u*)(hv + (size_t)(t0 + tok) * 1024 + h * 128 + dv0);
                VT[(dv0 + 0) * 68 + tok] = (bf16)(vv.x & 0xffffu); VT[(dv0 + 1) * 68 + tok] = (bf16)(vv.x >> 16);
                VT[(dv0 + 2) * 68 + tok] = (bf16)(vv.y & 0xffffu); VT[(dv0 + 3) * 68 + tok] = (bf16)(vv.y >> 16);
                VT[(dv0 + 4) * 68 + tok] = (bf16)(vv.z & 0xffffu); VT[(dv0 + 5) * 68 + tok] = (bf16)(vv.z >> 16);
                VT[(dv0 + 6) * 68 + tok] = (bf16)(vv.w & 0xffffu); VT[(dv0 + 7) * 68 + tok] = (bf16)(vv.w >> 16); }
        }
        __syncthreads();
#pragma unroll 1
        for (int I2 = 0; I2 < 4; ++I2) {
            const s16x4 vfrag = *(const LAS s16x4*)(VT + (16 * w + dvl) * 68 + 16 * I2 + 4 * q4);
            if (OUT) {
                f32x4 o = (f32x4){0.f, 0.f, 0.f, 0.f};
#pragma unroll
                for (int j8 = 0; j8 < 8; ++j8) { const s16x4 qf = *(const LAS s16x4*)(Qt + (16 * I2 + dvl) * 136 + 16 * j8 + 4 * q4);
                    v2u sw; sw.x = pk2(S[j8][0], S[j8][1]); sw.y = pk2(S[j8][2], S[j8][3]);
                    o = __builtin_amdgcn_mfma_f32_16x16x16bf16_1k(qf, __builtin_bit_cast(s16x4, sw), o, 0, 0, 0); }
                f32x4 sc = (f32x4){0.f, 0.f, 0.f, 0.f};
#pragma unroll
                for (int jj = 0; jj < 4; ++jj) { const s16x8 kf = *(const LAS s16x8*)(Kt + (16 * I2 + dvl) * 136 + 32 * jj + 8 * q4), qf8 = *(const LAS s16x8*)(Qt + (16 * I2 + dvl) * 136 + 32 * jj + 8 * q4);
                    sc = __builtin_amdgcn_mfma_f32_16x16x32_bf16(kf, qf8, sc, 0, 0, 0); }
#pragma unroll
                for (int r = 0; r < 4; ++r) if (4 * q4 + r > dvl) sc[r] = 0.f;
                v2u pwv; pwv.x = pk2(sc[0], sc[1]); pwv.y = pk2(sc[2], sc[3]);
                o = __builtin_amdgcn_mfma_f32_16x16x16bf16_1k(__builtin_bit_cast(s16x4, pwv), vfrag, o, 0, 0, 0);
#pragma unroll
                for (int r = 0; r < 4; ++r) OS[(16 * I2 + 4 * q4 + r) * 132 + 16 * w + dvl] = o[r];
            }
#pragma unroll
            for (int j8 = 0; j8 < 8; ++j8) { const f32x4 dsc = *(const LAS f32x4*)(DV + I2 * 128 + 16 * j8 + 4 * q4);
                const s16x4 af = *(const LAS s16x4*)(KH + (I2 * 128 + 16 * j8 + dvl) * 16 + 4 * q4);
                S[j8] = __builtin_amdgcn_mfma_f32_16x16x16bf16_1k(af, vfrag, S[j8] * dsc, 0, 0, 0); }
        }
        __syncthreads();
        if (OUT) {
            const int t = tid >> 3, seg = tid & 7; float ov[16]; float ss = 0.f;
#pragma unroll
            for (int e = 0; e < 16; e += 4) { const f32x4 x4 = *(const LAS f32x4*)(OS + t * 132 + 16 * seg + e); ov[e] = x4.x; ov[e + 1] = x4.y; ov[e + 2] = x4.z; ov[e + 3] = x4.w; ss += (x4.x * x4.x + x4.y * x4.y) + (x4.z * x4.z + x4.w * x4.w); }
            ss += __shfl_xor(ss, 1); ss += __shfl_xor(ss, 2); ss += __shfl_xor(ss, 4);
            const float rsn = 1.0f / sqrtf(ss * (1.0f / 128.0f) + 1e-6f);
            const int cg0 = h * 128 + 16 * seg;
            const v4u g0 = *(const v4u*)(gs + (size_t)(t0 + t) * 1024 + cg0), g1 = *(const v4u*)(gs + (size_t)(t0 + t) * 1024 + cg0 + 8);
            const unsigned gw[8] = {g0.x, g0.y, g0.z, g0.w, g1.x, g1.y, g1.z, g1.w};
            unsigned ow[8];
#pragma unroll
            for (int e = 0; e < 8; ++e) { const float a = ov[2 * e] * rsn * gain[cg0 + 2 * e] * __uint_as_float(gw[e] << 16), bb = ov[2 * e + 1] * rsn * gain[cg0 + 2 * e + 1] * __uint_as_float(gw[e] & 0xffff0000u); ow[e] = pk2(a, bb); }
            v4u* op = (v4u*)(oab + (size_t)(t0 + t) * 2048 + cg0);
            op[0] = (v4u){ow[0], ow[1], ow[2], ow[3]}; op[1] = (v4u){ow[4], ow[5], ow[6], ow[7]};
        }
    }
    if (!OUT) {
        f32x4* lp = (f32x4*)(F.ws + WS_L) + (size_t)u * 4096 + w * 512 + lane;
#pragma unroll
        for (int j8 = 0; j8 < 8; ++j8) lp[j8 * 64] = S[j8];
        RED[I * 128 + k] = btot;
        __syncthreads();
        if (tid < 128) ((float*)(F.ws + WS_DTOT))[u * 128 + tid] = __expf((RED[tid] + RED[128 + tid]) + (RED[256 + tid] + RED[384 + tid]));
        __syncthreads();
    }
}
__device__ __forceinline__ void hgrn_scan(Frame& F) {
    const int idx = F.vcu * NTHR + F.tid; if (idx >= 8 * 4096) return;
    const int h = idx >> 12, e = idx & 4095, ln = e & 63, j8 = (e >> 6) & 7, dk0 = 16 * j8 + 4 * (ln >> 4);
    const f32x4* L = (const f32x4*)(F.ws + WS_L); f32x4* SI = (f32x4*)(F.ws + WS_SINIT); const float* DT = (const float*)(F.ws + WS_DTOT);
    f32x4 S = (f32x4){0.f, 0.f, 0.f, 0.f};
#pragma unroll 1
    for (int jb = 0; jb < 32; jb += 8) {
        f32x4 l[8], d[8];
#pragma unroll
        for (int i = 0; i < 8; ++i) { const int u = (jb + i) * 8 + h; l[i] = L[(size_t)u * 4096 + e]; d[i] = *(const f32x4*)(DT + u * 128 + dk0); }
#pragma unroll
        for (int i = 0; i < 8; ++i) { const int u = (jb + i) * 8 + h; SI[(size_t)u * 4096 + e] = S; S = S * d[i] + l[i]; }
    }
}

constexpr int AL_K = 0, AL_VT = 36864, AL_L = 36864 + 33792;
__device__ __forceinline__ int crow(int r, int hi) { return (r & 3) + 8 * (r >> 2) + 4 * hi; }
__device__ __forceinline__ void attn_unit(Frame& F, int u, const float* sinks) {
    const int n = u >> 2, kvh = u & 3, tid = F.tid, lane = F.lane, w = F.wave, r32 = lane & 31, hi = lane >> 5;
    const bf16* aq = (const bf16*)(F.ws + WS_AQ); const bf16* ak = (const bf16*)(F.ws + WS_AK); const bf16* av = (const bf16*)(F.ws + WS_AV); bf16* oab = (bf16*)(F.ws + WS_OAB);
    LAS bf16* Ks = (LAS bf16*)(F.lds + AL_K); LAS bf16* VT = (LAS bf16*)(F.lds + AL_VT); LAS float* LW = (LAS float*)(F.lds + AL_L) + w * 32;
    __syncthreads();
#pragma unroll
    for (int c = 0; c < 4; ++c) { const int ch = tid + 512 * c, s = ch >> 3, d0 = (ch & 7) * 8; const int tok = 128 * (n - 1) + s;
        v4u kv = (v4u){0u, 0u, 0u, 0u}, vv = (v4u){0u, 0u, 0u, 0u};
        if (tok >= 0) { kv = *(const v4u*)(ak + (size_t)tok * 256 + kvh * 64 + d0); vv = *(const v4u*)(av + (size_t)tok * 256 + kvh * 64 + d0); }
        *(LAS v4u*)(Ks + s * 72 + d0) = kv;
        VT[(d0 + 0) * 264 + s] = (bf16)(vv.x & 0xffffu); VT[(d0 + 1) * 264 + s] = (bf16)(vv.x >> 16);
        VT[(d0 + 2) * 264 + s] = (bf16)(vv.y & 0xffffu); VT[(d0 + 3) * 264 + s] = (bf16)(vv.y >> 16);
        VT[(d0 + 4) * 264 + s] = (bf16)(vv.z & 0xffffu); VT[(d0 + 5) * 264 + s] = (bf16)(vv.z >> 16);
        VT[(d0 + 6) * 264 + s] = (bf16)(vv.w & 0xffffu); VT[(d0 + 7) * 264 + s] = (bf16)(vv.w >> 16); }
    __syncthreads();
    const int g = w >> 1, hq = kvh * 4 + g; const float sink2 = sinks[hq] * LOG2E;
#pragma unroll 1
    for (int sb = 0; sb < 2; ++sb) {
        const int q0 = (w & 1) * 64 + 32 * sb, a = q0 >> 5;
        s16x8 qr[4];
#pragma unroll
        for (int d0 = 0; d0 < 4; ++d0) qr[d0] = *(const s16x8*)(aq + (size_t)(128 * n + q0 + r32) * 1024 + hq * 64 + 16 * d0 + 8 * hi);
        f32x16 sc[5];
#pragma unroll
        for (int kt = 0; kt < 5; ++kt) { sc[kt] = (f32x16){};
#pragma unroll
            for (int d0 = 0; d0 < 4; ++d0) { const s16x8 kf = *(const LAS s16x8*)(Ks + (32 * (a + kt) + r32) * 72 + 16 * d0 + 8 * hi);
                sc[kt] = __builtin_amdgcn_mfma_f32_32x32x16_bf16(kf, qr[d0], sc[kt], 0, 0, 0); } }
        const int qi = q0 + r32; float mx = sink2;
#pragma unroll
        for (int kt = 0; kt < 5; ++kt)
#pragma unroll
            for (int r = 0; r < 16; ++r) { const int s = 32 * (a + kt) + crow(r, hi); const bool ok = (s > qi) && (s <= qi + 128) && (n > 0 || s >= 128);
                sc[kt][r] = ok ? sc[kt][r] : -INFINITY; mx = fmaxf(mx, sc[kt][r]); }
        mx = fmaxf(mx, __shfl_xor(mx, 32));
        float l = 0.f;
#pragma unroll
        for (int kt = 0; kt < 5; ++kt)
#pragma unroll
            for (int r = 0; r < 16; ++r) { const float p = __builtin_amdgcn_exp2f(sc[kt][r] - mx); sc[kt][r] = p; l += p; }
        l += __shfl_xor(l, 32); l += __builtin_amdgcn_exp2f(sink2 - mx);
        if (hi == 0) LW[r32] = 1.0f / l;
        f32x16 o[2]; o[0] = (f32x16){}; o[1] = (f32x16){};
#pragma unroll
        for (int kt = 0; kt < 5; ++kt)
#pragma unroll
            for (int sl = 0; sl < 2; ++sl) {
                v4u pw; pw.x = pk2(sc[kt][8 * sl + 0], sc[kt][8 * sl + 1]); pw.y = pk2(sc[kt][8 * sl + 2], sc[kt][8 * sl + 3]); pw.z = pk2(sc[kt][8 * sl + 4], sc[kt][8 * sl + 5]); pw.w = pk2(sc[kt][8 * sl + 6], sc[kt][8 * sl + 7]);
                const s16x8 pf = __builtin_bit_cast(s16x8, pw); const int kb = 32 * (a + kt) + 16 * sl + 4 * hi;
#pragma unroll
                for (int dt = 0; dt < 2; ++dt) { const v2u v0 = *(const LAS v2u*)(VT + (32 * dt + r32) * 264 + kb), v1 = *(const LAS v2u*)(VT + (32 * dt + r32) * 264 + kb + 8);
                    const v4u vw = (v4u){v0.x, v0.y, v1.x, v1.y};
                    o[dt] = __builtin_amdgcn_mfma_f32_32x32x16_bf16(pf, __builtin_bit_cast(s16x8, vw), o[dt], 0, 0, 0); } }
        LDS_WAIT(); asm volatile("" ::: "memory");
        bf16* op = oab + (size_t)(128 * n + q0) * 2048 + 1024 + hq * 64 + r32;
#pragma unroll
        for (int r = 0; r < 16; ++r) { const int qq = crow(r, hi); const float li = LW[qq];
            op[(size_t)qq * 2048] = (bf16)f2bf(o[0][r] * li); op[(size_t)qq * 2048 + 32] = (bf16)f2bf(o[1][r] * li); }
        LDS_WAIT(); asm volatile("" ::: "memory");
    }
}

struct Args { const float* in[14]; float* out; unsigned char* ws; };
__global__ void __launch_bounds__(NTHR, 2) fwd_kernel(Args args) {
    extern __shared__ __attribute__((aligned(16))) unsigned char lds[];
    cg::grid_group grid = cg::this_grid();
    Frame F; F.lds = (LAS unsigned char*)lds; F.tid = threadIdx.x; F.lane = F.tid & 63; F.wave = __builtin_amdgcn_readfirstlane(F.tid >> 6);
    F.G = gridDim.x; { const int bx = blockIdx.x; F.vcu = (F.G % 8 == 0) ? (bx % 8) * (F.G / 8) + bx / 8 : bx; }
    F.ws = args.ws;
    const float* x = args.in[0]; const float* w_in = args.in[1]; const float* lbl = args.in[2]; const float* hgain = args.in[3]; const float* sinks = args.in[4];
    const float* w_a = args.in[5]; const float* w_b = args.in[6]; const float* w_out = args.in[7]; const float* ln1g = args.in[8]; const float* ln1b = args.in[9];
    const float* w_ff1 = args.in[10]; const float* w_ff2 = args.in[11]; const float* ln2g = args.in[12]; const float* ln2b = args.in[13];
    unsigned char* ws = args.ws; float* out = args.out;
    const int gtid = F.vcu * NTHR + F.tid, GT = F.G * NTHR;

    transpose_weight(F, w_in, DM, DIN, (bf16*)(ws + WS_WIN), DM, 0, true);
    for (size_t i = gtid; i < (size_t)SEQ * DM / 4; i += GT) { const f32x4 v = ((const f32x4*)x)[i]; v2u o; o.x = pk2(v.x, v.y); o.y = pk2(v.z, v.w); ((v2u*)(ws + WS_XB))[i] = o; }
    for (int i = gtid; i < SEQ * 32; i += GT) { const int pos = i >> 5, fi = i & 31; const float inv = exp2f(-(float)fi * (13.287712379549449f / 32.0f));
        const float ang = (float)pos * inv; double rv = (double)ang * 0.15915494309189535; rv -= floor(rv); const float rf = (float)rv;
        float* rp = (float*)(ws + WS_ROPE) + (size_t)pos * 64 + fi; rp[0] = __builtin_amdgcn_cosf(rf); rp[32] = __builtin_amdgcn_sinf(rf); }
    grid.sync();
    { pg8::Gemm g{(const pg8::bf16_t*)(ws + WS_XB), (const pg8::bf16_t*)(ws + WS_WIN), SEQ, DIN, DM}; pg8::StaticOrder S; S.init(SEQ, DIN, F.G, (int)blockIdx.x);
#ifndef SKIP_G0
      pg8::Epi E{0, ws, x, lbl, out}; pg8::gemm_phase<pg8::Epi, pg8::StaticOrder, true, true>(F.lds, g, S, E); }
#else
 }
#endif
    grid.sync();
#ifndef SKIP_HA
    for (int u = blockIdx.x; u < 256; u += F.G) hgrn_unit<false>(F, u, hgain);
#endif
#ifndef SKIP_AT
    for (int u = blockIdx.x; u < 256; u += F.G) attn_unit(F, u, sinks);
#endif
    grid.sync();
#ifndef SKIP_SC
    hgrn_scan(F);
#endif
    transpose_weight(F, w_a, 1024, DM, (bf16*)(ws + WS_WAB), 2048, 0, false);
    transpose_weight(F, w_b, 1024, DM, (bf16*)(ws + WS_WAB), 2048, 1024, false);
    transpose_weight(F, w_out, DM, DM, (bf16*)(ws + WS_WOUT), 2048, 0, false);
    grid.sync();
#ifndef SKIP_HC
    for (int u = blockIdx.x; u < 256; u += F.G) hgrn_unit<true>(F, u, hgain);
#endif
    grid.sync();
    { pg8::Gemm g{(const pg8::bf16_t*)(ws + WS_OAB), (const pg8::bf16_t*)(ws + WS_WAB), SEQ, DM, 2048}; pg8::StaticOrder S; S.init(SEQ, DM, F.G, (int)blockIdx.x);
#ifndef SKIP_G1
      pg8::Epi E{1, ws, x, lbl, out}; pg8::gemm_phase<pg8::Epi, pg8::StaticOrder, true, true>(F.lds, g, S, E); }
#else
 }
#endif
    grid.sync();
    { pg8::Gemm g{(const pg8::bf16_t*)(ws + WS_MIX), (const pg8::bf16_t*)(ws + WS_WOUT), SEQ, DM, DM}; pg8::StaticOrder S; S.init(SEQ, DM, F.G, (int)blockIdx.x);
#ifndef SKIP_G2
      pg8::Epi E{2, ws, x, lbl, out}; pg8::gemm_phase<pg8::Epi, pg8::StaticOrder, true, true>(F.lds, g, S, E); }
#else
 }
#endif
    grid.sync();
    ln_phase(F, out, ln1g, ln1b, (bf16*)(ws + WS_X1B));
    transpose_weight(F, w_ff1, DM, DFF, (bf16*)(ws + WS_W1), DM, 0, false);
    transpose_weight(F, w_ff2, DFF, DM, (bf16*)(ws + WS_W2), DFF, 0, false);
    grid.sync();
    { pg8::Gemm g{(const pg8::bf16_t*)(ws + WS_X1B), (const pg8::bf16_t*)(ws + WS_W1), SEQ, DFF, DM}; pg8::StaticOrder S; S.init(SEQ, DFF, F.G, (int)blockIdx.x);
#ifndef SKIP_G3
      pg8::Epi E{3, ws, x, lbl, out}; pg8::gemm_phase<pg8::Epi, pg8::StaticOrder, true, true>(F.lds, g, S, E); }
#else
 }
#endif
    grid.sync();
    { pg8::Gemm g{(const pg8::bf16_t*)(ws + WS_H1), (const pg8::bf16_t*)(ws + WS_W2), SEQ, DM, DFF}; pg8::StaticOrder S; S.init(SEQ, DM, F.G, (int)blockIdx.x);
#ifndef SKIP_G4
      pg8::Epi E{4, ws, x, lbl, out}; pg8::gemm_phase<pg8::Epi, pg8::StaticOrder, true, true>(F.lds, g, S, E); }
#else
 }
#endif
    grid.sync();
    ln_phase(F, out, ln2g, ln2b, nullptr);
}

extern "C" void kernel_launch(void* const* d_in, const int* in_sizes, int n_in, void* d_out, int out_size, void* d_ws, size_t ws_size, hipStream_t stream) {
    static int grid = 0;
    if (grid == 0) {
        if (n_in != 14 || in_sizes[0] != SEQ * DM || out_size != SEQ * DM || ws_size < WS_END) { fprintf(stderr, "kernel_launch: unexpected shapes (n_in %d, ws %zu)\n", n_in, ws_size); grid = -1; return; }
        int dev = 0, cus = 0, per_cu = 0;
        hipGetDevice(&dev); hipDeviceGetAttribute(&cus, hipDeviceAttributeMultiprocessorCount, dev);
        if (hipFuncSetAttribute((const void*)fwd_kernel, hipFuncAttributeMaxDynamicSharedMemorySize, LDS_BYTES) != hipSuccess) { fprintf(stderr, "kernel_launch: hipFuncSetAttribute failed\n"); grid = -1; return; }
        if (hipOccupancyMaxActiveBlocksPerMultiprocessor(&per_cu, (const void*)fwd_kernel, NTHR, LDS_BYTES) != hipSuccess || per_cu < 1) { fprintf(stderr, "kernel_launch: occupancy query says %d\n", per_cu); per_cu = 1; }
        (void)hipGetLastError();
        grid = cus * (per_cu > 1 ? 1 : per_cu);
    }
    if (grid < 0) return;
    Args a{};
    for (int i = 0; i < 14; ++i) a.in[i] = (const float*)d_in[i];
    a.out = (float*)d_out; a.ws = (unsigned char*)d_ws;
    void* kargs[] = {&a};
    hipError_t e = hipLaunchCooperativeKernel((const void*)fwd_kernel, dim3(grid), dim3(NTHR), kargs, LDS_BYTES, stream);
    if (e != hipSuccess) fprintf(stderr, "kernel_launch: cooperative launch failed: %s (grid %d)\n", hipGetErrorString(e), grid);
}
```

```cpp
#include <hip/hip_runtime.h>
#include <hip/hip_cooperative_groups.h>
#include <cstdio>
#include <cstdint>
namespace cg = cooperative_groups;

constexpr int SEQ = 8192, DM = 2048, DIN = 9728, DFF = 8192;
constexpr float ALPHA = 1.189207115002721f;
constexpr float LOG2E = 1.4426950408889634f;
constexpr size_t MiB = 1ull << 20;
constexpr size_t WS_CTL = 0, WS_ROPE = 1 * MiB, WS_DTOT = 3 * MiB;
constexpr size_t WS_WIN = 4 * MiB, WS_XB = 42 * MiB;
constexpr size_t WS_WAB = 4 * MiB, WS_WOUT = 12 * MiB;
constexpr size_t WS_L = 20 * MiB, WS_SINIT = 36 * MiB;
constexpr size_t WS_W1 = 20 * MiB, WS_W2 = 52 * MiB;
constexpr size_t WS_SGA = 84 * MiB, WS_X1B = 84 * MiB;
constexpr size_t WS_SGB = 116 * MiB, WS_OAB = 148 * MiB, WS_LF = 180 * MiB, WS_AQ = 212 * MiB;
constexpr size_t WS_H1 = 116 * MiB;
constexpr size_t WS_QH = 244 * MiB, WS_HV = 260 * MiB, WS_MIX = 244 * MiB, WS_GS = 276 * MiB, WS_AK = 292 * MiB, WS_AV = 296 * MiB;
constexpr size_t WS_END = 300 * MiB;
namespace pg8 {
#define PG8_LAS __attribute__((address_space(3)))
typedef unsigned short bf16_t;
typedef short bf16x8 __attribute__((ext_vector_type(8)));
typedef float f32x4 __attribute__((ext_vector_type(4)));
typedef unsigned u32x4 __attribute__((ext_vector_type(4)));
typedef unsigned u32x2 __attribute__((ext_vector_type(2)));
constexpr int BM = 256, BK = 64, HALF = 128, HTB = HALF * BK * 2  , STAGE_BYTES = 8 * HTB, NXCD = 8, WGM = 8;

__host__ __device__ __forceinline__ int lds_byte(int r, int c) { const int st = (r >> 4) * 2 + (c >> 5), rr = r & 15, cc = c & 31, ob = rr * 64 + cc * 2; return st * 1024 + (ob ^ (((ob >> 9) & 1) << 5)); }
__host__ __device__ __forceinline__ void stage_rc(int b, int& R, int& C) { const int st = b / 1024, sb = b % 1024, swz = sb ^ (((sb >> 9) & 1) << 5); R = (st >> 1) * 16 + swz / 64; C = (st & 1) * 32 + (swz % 64) / 2; }
__host__ __device__ __forceinline__ int perm32(int rho) { const int n = rho >> 4, i = rho & 15; return 8 * (i >> 2) + 4 * n + (i & 3); }

struct Unit { int pm, pn; };
struct Gemm { const bf16_t* A; const bf16_t* Bt; int M, N, K; };

struct StaticOrder {
    int nM, nN, nwg, G, c;
    __host__ __device__ void init(int M, int N, int G_, int c_) { nM = M / BM; nN = N / BM; nwg = nM * nN; G = G_; c = c_; }
    __host__ __device__ bool next(int i, Unit& u) const {
        const long L = (long)i * G + c; if (L >= nwg) return false;
        int wgid = (int)L; { const int q = nwg / NXCD, r = nwg % NXCD, xcd = wgid % NXCD, off = wgid / NXCD; wgid = (xcd < r ? xcd * (q + 1) : r * (q + 1) + (xcd - r) * q) + off; }
        const int nig = WGM * nN, gid = wgid / nig, fm = gid * WGM, gsz = (nM - fm) < WGM ? (nM - fm) : WGM;
        u.pm = fm + ((wgid % nig) % gsz); u.pn = (wgid % nig) / gsz; return true;
    }
    __device__ __forceinline__ void a_ready(const Unit&) const {}
    __device__ __forceinline__ void done(const Unit&) const {}
};

__device__ __forceinline__ unsigned cvt_pk_bf16(float lo, float hi) { unsigned r; asm volatile("v_cvt_pk_bf16_f32 %0, %1, %2" : "=v"(r) : "v"(lo), "v"(hi)); return r; }
__device__ __forceinline__ float bflo(unsigned w) { return __uint_as_float(w << 16); }
__device__ __forceinline__ float bfhi(unsigned w) { return __uint_as_float(w & 0xffff0000u); }
__device__ __forceinline__ float fsigm(float v) { return __builtin_amdgcn_rcpf(1.0f + __expf(-v)); }
enum { OP_NONE = 0, OP_SILU = 1, OP_SIGM = 2, OP_RELU2 = 3, OP_GATE = 4, OP_LF = 5, OP_ROPE = 6, OP_RES = 7 };
struct Epi {
    static constexpr bool PERM = true, AFTER_DRAIN = false;
    int mode; unsigned char* ws; const float* x; const float* lbl; float* out;
    __device__ __forceinline__ void mid(f32x4 (&acc)[2][2][4][2], const Unit& u, int wr, int wc, int fr, int fq) const {
        const bf16_t* ga = (const bf16_t*)(ws + WS_SGA); const bf16_t* gb = (const bf16_t*)(ws + WS_SGB);
        int row0 = u.pm * BM + wr * 64 + fr, col0 = u.pn * BM + wc * 32 + 8 * fq;
        asm volatile("" : "+v"(row0), "+v"(col0));
#pragma unroll
        for (int ai = 0; ai < 2; ++ai)
#pragma unroll
            for (int m = 0; m < 4; ++m)
#pragma unroll
                for (int bj = 0; bj < 2; ++bj) {
                    const size_t off = (size_t)(row0 + ai * HALF + m * 16) * 2048 + col0 + bj * HALF;
                    const u32x4 a = *(const u32x4*)(ga + off), b = *(const u32x4*)(gb + off);
                    f32x4 r0, r1;
                    r0[0] = bflo(a.x) * __builtin_amdgcn_rcpf(bflo(b.x)); r0[1] = bfhi(a.x) * __builtin_amdgcn_rcpf(bfhi(b.x));
                    r0[2] = bflo(a.y) * __builtin_amdgcn_rcpf(bflo(b.y)); r0[3] = bfhi(a.y) * __builtin_amdgcn_rcpf(bfhi(b.y));
                    r1[0] = bflo(a.z) * __builtin_amdgcn_rcpf(bflo(b.z)); r1[1] = bfhi(a.z) * __builtin_amdgcn_rcpf(bfhi(b.z));
                    r1[2] = bflo(a.w) * __builtin_amdgcn_rcpf(bflo(b.w)); r1[3] = bfhi(a.w) * __builtin_amdgcn_rcpf(bfhi(b.w));
                    acc[ai][bj][m][0] *= r0; acc[ai][bj][m][1] *= r1;
                    asm volatile("" : "+v"(acc[ai][bj][m][0]), "+v"(acc[ai][bj][m][1]) :: "memory");
                }
    }
    __device__ __forceinline__ void operator()(const f32x4 (&acc)[2][2][4][2], const Unit& u, int wr, int wc, int fr, int fq) const {
        const int row0 = u.pm * BM + wr * 64 + fr, ct0 = wc * 32 + 8 * fq, pn = u.pn;
        int op; bf16_t* dst = nullptr; int ld = 0, cb = 0; float rs = 1.0f;
        if (mode == 0) {
            if (pn < 4)        { op = OP_SILU; dst = (bf16_t*)(ws + WS_QH); ld = 1024; cb = pn * 256; }
            else if (pn < 8)   { op = OP_LF; cb = (pn - 4) * 256; }
            else if (pn < 12)  { op = OP_NONE; dst = (bf16_t*)(ws + WS_HV); ld = 1024; cb = (pn - 8) * 256; }
            else if (pn < 16)  { op = OP_SILU; dst = (bf16_t*)(ws + WS_GS); ld = 1024; cb = (pn - 12) * 256; }
            else if (pn < 20)  { op = OP_ROPE; dst = (bf16_t*)(ws + WS_AQ); ld = 1024; cb = (pn - 16) * 256; rs = 0.125f * LOG2E; }
            else if (pn == 20) { op = OP_ROPE; dst = (bf16_t*)(ws + WS_AK); ld = 256; cb = 0; }
            else if (pn == 21) { op = OP_NONE; dst = (bf16_t*)(ws + WS_AV); ld = 256; cb = 0; }
            else if (pn < 30)  { op = OP_SIGM; dst = (bf16_t*)(ws + WS_SGA); ld = 2048; cb = (pn - 22) * 256; }
            else               { op = OP_SIGM; dst = (bf16_t*)(ws + WS_SGB); ld = 2048; cb = (pn - 30) * 256; }
        } else if (mode == 1)  { op = OP_GATE; dst = (bf16_t*)(ws + WS_MIX); ld = 2048; cb = pn * 256; }
        else if (mode == 3)    { op = OP_RELU2; dst = (bf16_t*)(ws + WS_H1); ld = 8192; cb = pn * 256; }
        else op = OP_RES;
        if (op <= OP_GATE) {
            const bf16_t* gb = (const bf16_t*)(ws + WS_SGB);
#pragma unroll
            for (int ai = 0; ai < 2; ++ai)
#pragma unroll
                for (int m = 0; m < 4; ++m) { const int row = row0 + ai * HALF + m * 16;
#pragma unroll
                    for (int bj = 0; bj < 2; ++bj) { f32x4 v0 = acc[ai][bj][m][0], v1 = acc[ai][bj][m][1]; const int c = cb + ct0 + bj * HALF;
                        if (op == OP_SILU) {
#pragma unroll
                            for (int e = 0; e < 4; ++e) { v0[e] *= fsigm(v0[e]); v1[e] *= fsigm(v1[e]); }
                        } else if (op == OP_SIGM) {
#pragma unroll
                            for (int e = 0; e < 4; ++e) { v0[e] = fsigm(v0[e]); v1[e] = fsigm(v1[e]); }
                        } else if (op == OP_RELU2) {
#pragma unroll
                            for (int e = 0; e < 4; ++e) { const float a = fmaxf(v0[e], 0.f), b = fmaxf(v1[e], 0.f); v0[e] = a * a; v1[e] = b * b; }
                        } else if (op == OP_GATE) {
                            const u32x4 g = *(const u32x4*)(gb + (size_t)row * 2048 + c);
                            v0[0] *= bflo(g.x); v0[1] *= bfhi(g.x); v0[2] *= bflo(g.y); v0[3] *= bfhi(g.y);
                            v1[0] *= bflo(g.z); v1[1] *= bfhi(g.z); v1[2] *= bflo(g.w); v1[3] *= bfhi(g.w);
                        }
                        u32x4 w; w.x = cvt_pk_bf16(v0[0], v0[1]); w.y = cvt_pk_bf16(v0[2], v0[3]); w.z = cvt_pk_bf16(v1[0], v1[1]); w.w = cvt_pk_bf16(v1[2], v1[3]);
                        *(u32x4*)(dst + (size_t)row * ld + c) = w; } }
        } else if (op == OP_LF) {
            float* lf = (float*)(ws + WS_LF);
#pragma unroll
            for (int bj = 0; bj < 2; ++bj) { const int c = cb + ct0 + bj * HALF;
                const f32x4 a0 = *(const f32x4*)(lbl + c), a1 = *(const f32x4*)(lbl + c + 4), b0 = *(const f32x4*)(lbl + 1024 + c), b1 = *(const f32x4*)(lbl + 1024 + c + 4);
                f32x4 lb0, lb1;
#pragma unroll
                for (int e = 0; e < 4; ++e) { lb0[e] = fsigm(a0[e] - b0[e]); lb1[e] = fsigm(a1[e] - b1[e]); }
#pragma unroll
                for (int ai = 0; ai < 2; ++ai)
#pragma unroll
                    for (int m = 0; m < 4; ++m) { const int row = row0 + ai * HALF + m * 16; f32x4 v0 = acc[ai][bj][m][0], v1 = acc[ai][bj][m][1];
#pragma unroll
                        for (int e = 0; e < 4; ++e) { v0[e] = __logf(lb0[e] + (1.0f - lb0[e]) * fsigm(v0[e])); v1[e] = __logf(lb1[e] + (1.0f - lb1[e]) * fsigm(v1[e])); }
                        *(f32x4*)(lf + (size_t)row * 1024 + c) = v0; *(f32x4*)(lf + (size_t)row * 1024 + c + 4) = v1; } }
        } else if (op == OP_ROPE) {
            const float* rope = (const float*)(ws + WS_ROPE); const int i0 = 16 * (wc & 1) + 4 * fq;
#pragma unroll
            for (int ai = 0; ai < 2; ++ai)
#pragma unroll
                for (int m = 0; m < 4; ++m) { const int row = row0 + ai * HALF + m * 16;
                    const f32x4 cs = *(const f32x4*)(rope + (size_t)row * 64 + i0), sn = *(const f32x4*)(rope + (size_t)row * 64 + 32 + i0);
#pragma unroll
                    for (int bj = 0; bj < 2; ++bj) { const f32x4 t1 = acc[ai][bj][m][0], t2 = acc[ai][bj][m][1];
                        const f32x4 o1 = (t1 * cs - t2 * sn) * rs, o2 = (t2 * cs + t1 * sn) * rs;
                        const int hc = cb + bj * HALF + (wc >> 1) * 64 + i0;
                        u32x2 w1, w2; w1.x = cvt_pk_bf16(o1[0], o1[1]); w1.y = cvt_pk_bf16(o1[2], o1[3]); w2.x = cvt_pk_bf16(o2[0], o2[1]); w2.y = cvt_pk_bf16(o2[2], o2[3]);
                        *(u32x2*)(dst + (size_t)row * ld + hc) = w1; *(u32x2*)(dst + (size_t)row * ld + hc + 32) = w2; } }
        } else {
            const float* src = (mode == 2) ? x : out;
#pragma unroll
            for (int ai = 0; ai < 2; ++ai)
#pragma unroll
                for (int m = 0; m < 4; ++m) { const int row = row0 + ai * HALF + m * 16;
#pragma unroll
                    for (int bj = 0; bj < 2; ++bj) { const size_t off = (size_t)row * DM + pn * 256 + ct0 + bj * HALF;
                        const f32x4 s0 = *(const f32x4*)(src + off), s1 = *(const f32x4*)(src + off + 4);
                        *(f32x4*)(out + off) = s0 * ALPHA + acc[ai][bj][m][0]; *(f32x4*)(out + off + 4) = s1 * ALPHA + acc[ai][bj][m][1]; } }
        }
    }
};
template <class Epi, class Sched, bool ALIGN_EPI = false, bool SP2 = false>
__device__ __forceinline__ void gemm_phase(PG8_LAS unsigned char* lds, const Gemm g, const Sched& S, const Epi& E) {
    const int tid = threadIdx.x, wid = __builtin_amdgcn_readfirstlane(tid >> 6), lane = tid & 63, wr = wid >> 2, wc = wid & 3, fr = lane & 15, fq = lane >> 4;
    const int K = g.K, nt = K / BK;
    unsigned voffA[2], voffB[2];
#pragma unroll
    for (int i = 0; i < 2; ++i) { int R, C; stage_rc(tid * 16 + i * 8192, R, C); const int Rb = Epi::PERM ? ((R & ~31) + perm32(R & 31)) : R;
        voffA[i] = (unsigned)(R * K + C) * 2u; voffB[i] = (unsigned)(Rb * K + C) * 2u; }
    const size_t kstep = (size_t)(BK * 2);
    const size_t hstep = (size_t)HALF * K * 2;
    const size_t tstep = 2 * hstep;
    const unsigned ldsw = (unsigned)wid * 1024u;
    const int aoff = lds_byte(wr * 64 + fr, fq * 8), boff = lds_byte(wc * 32 + fr, fq * 8);
#define PG8_SA(b, h) (((b) * 2 + (h)) * HTB)
#define PG8_SB(b, h) ((4 + (b) * 2 + (h)) * HTB)
#define PG8_STAGE(bufoff, gbase, voff) do { _Pragma("unroll") for (int _i = 0; _i < 2; ++_i) \
        __builtin_amdgcn_global_load_lds((const unsigned*)((const char*)(gbase) + (voff)[_i]), (PG8_LAS unsigned*)(lds + (bufoff) + ldsw + _i * 8192), 16, 0, 0); } while (0)
#define PG8_LDA(dst, b, h) do { _Pragma("unroll") for (int m = 0; m < 4; ++m) _Pragma("unroll") for (int k = 0; k < 2; ++k) dst[m][k] = *(const PG8_LAS bf16x8*)(lds + PG8_SA(b, h) + aoff + m * 2048 + k * 1024); } while (0)
#define PG8_LDB(dst, b, h) do { _Pragma("unroll") for (int n = 0; n < 2; ++n) _Pragma("unroll") for (int k = 0; k < 2; ++k) dst[n][k] = *(const PG8_LAS bf16x8*)(lds + PG8_SB(b, h) + boff + n * 2048 + k * 1024); } while (0)
#define PG8_MMA(ai, bj, At, Bt) do { __builtin_amdgcn_s_setprio(1); _Pragma("unroll") for (int m = 0; m < 4; ++m) _Pragma("unroll") for (int n = 0; n < 2; ++n) _Pragma("unroll") for (int k = 0; k < 2; ++k) \
        acc[ai][bj][m][n] = __builtin_amdgcn_mfma_f32_16x16x32_bf16(Bt[n][k], At[m][k], acc[ai][bj][m][n], 0, 0, 0); __builtin_amdgcn_s_setprio(0); } while (0)
#define PG8_WAIT_V(n) asm volatile("s_waitcnt vmcnt(" #n ")" ::: "memory")
#define PG8_WAIT_L(n) asm volatile("s_waitcnt lgkmcnt(" #n ")" ::: "memory")
#define PG8_BAR __builtin_amdgcn_s_barrier()
#define PG8_SCHED __builtin_amdgcn_sched_barrier(0)
    Unit cur, nxt; int ui = 0;
    if (!S.next(0, cur)) return;
    f32x4 acc[2][2][4][2];
#pragma unroll
    for (int a = 0; a < 2; ++a)
#pragma unroll
        for (int b = 0; b < 2; ++b)
#pragma unroll
            for (int m = 0; m < 4; ++m)
#pragma unroll
                for (int n = 0; n < 2; ++n) acc[a][b][m][n] = (f32x4){0.f, 0.f, 0.f, 0.f};
    bf16x8 At[4][2], B0[2][2], B1[2][2];
    const char* cA = (const char*)g.A + (size_t)cur.pm * tstep; const char* cB = (const char*)g.Bt + (size_t)cur.pn * tstep;
    S.a_ready(cur);
    if constexpr (SP2) {
        PG8_STAGE(PG8_SB(0, 0), cB, voffB); PG8_STAGE(PG8_SB(0, 1), cB + hstep, voffB); PG8_STAGE(PG8_SA(0, 0), cA, voffA); PG8_STAGE(PG8_SA(0, 1), cA + hstep, voffA);
        if (wr == 1) PG8_BAR;
        PG8_WAIT_V(2); PG8_BAR;
        PG8_STAGE(PG8_SB(1, 0), cB + kstep, voffB); PG8_STAGE(PG8_SA(1, 0), cA + kstep, voffA); PG8_STAGE(PG8_SB(1, 1), cB + hstep + kstep, voffB);
        PG8_WAIT_V(6); PG8_BAR;
    } else {
        PG8_STAGE(PG8_SB(0, 0), cB, voffB); PG8_STAGE(PG8_SA(0, 0), cA, voffA); PG8_STAGE(PG8_SB(0, 1), cB + hstep, voffB); PG8_STAGE(PG8_SA(0, 1), cA + hstep, voffA);
        if (wr == 1) PG8_BAR;
        PG8_WAIT_V(4); PG8_BAR;
        PG8_STAGE(PG8_SB(1, 0), cB + kstep, voffB); PG8_STAGE(PG8_SA(1, 0), cA + kstep, voffA); PG8_STAGE(PG8_SB(1, 1), cB + hstep + kstep, voffB);
        PG8_WAIT_V(6); PG8_BAR;
    }
    for (;;) {
        const bool has_next = S.next(ui + 1, nxt);
        const char* nA = has_next ? (const char*)g.A + (size_t)nxt.pm * tstep : cA; const char* nB = has_next ? (const char*)g.Bt + (size_t)nxt.pn * tstep : cB;
        for (int t = 0; t < nt; t += 2) {
            if (E.mode == 1 && t == (nt >> 1)) E.mid(acc, cur, wr, wc, fr, fq);
            const bool last = (t == nt - 2);
            const char* a1 = cA + (size_t)(t + 1) * kstep;
            const char* a2 = last ? nA : cA + (size_t)(t + 2) * kstep; const char* b2 = last ? nB : cB + (size_t)(t + 2) * kstep;
            const char* a3 = a2 + kstep; const char* b3 = b2 + kstep;
            if (last && has_next) S.a_ready(nxt);
            if constexpr (SP2) {
            PG8_LDB(B0, 0, 0); PG8_LDB(B1, 0, 1); PG8_SCHED; PG8_LDA(At, 0, 0); PG8_STAGE(PG8_SA(1, 1), a1 + hstep, voffA);
            PG8_WAIT_V(8); PG8_WAIT_L(0); PG8_BAR; PG8_MMA(0, 0, At, B0); PG8_MMA(0, 1, At, B1); PG8_BAR; PG8_SCHED;
            PG8_LDA(At, 0, 1); PG8_STAGE(PG8_SB(0, 0), b2, voffB); PG8_STAGE(PG8_SB(0, 1), b2 + hstep, voffB); PG8_STAGE(PG8_SA(0, 0), a2, voffA);
            PG8_WAIT_V(8); PG8_WAIT_L(0); PG8_BAR; PG8_MMA(1, 0, At, B0); PG8_MMA(1, 1, At, B1); PG8_BAR; PG8_SCHED;
            PG8_LDB(B0, 1, 0); PG8_LDB(B1, 1, 1); PG8_SCHED; PG8_LDA(At, 1, 0); PG8_STAGE(PG8_SA(0, 1), a2 + hstep, voffA);
            PG8_WAIT_V(8); PG8_WAIT_L(0); PG8_BAR; PG8_MMA(0, 0, At, B0); PG8_MMA(0, 1, At, B1); PG8_BAR; PG8_SCHED;
            PG8_LDA(At, 1, 1); PG8_STAGE(PG8_SB(1, 0), b3, voffB); PG8_STAGE(PG8_SB(1, 1), b3 + hstep, voffB); PG8_STAGE(PG8_SA(1, 0), a3, voffA);
            PG8_WAIT_V(8); PG8_WAIT_L(0); PG8_BAR; PG8_MMA(1, 0, At, B0); PG8_MMA(1, 1, At, B1); PG8_BAR; PG8_SCHED;
            } else {
            PG8_LDB(B0, 0, 0); PG8_SCHED; PG8_LDA(At, 0, 0); PG8_STAGE(PG8_SA(1, 1), a1 + hstep, voffA);
            PG8_WAIT_L(8); PG8_BAR; PG8_WAIT_L(0); PG8_MMA(0, 0, At, B0); PG8_BAR; PG8_SCHED;
            PG8_LDB(B1, 0, 1); PG8_STAGE(PG8_SB(0, 0), b2, voffB);
            PG8_BAR; PG8_WAIT_L(0); PG8_MMA(0, 1, At, B1); PG8_BAR;
            PG8_LDA(At, 0, 1); PG8_STAGE(PG8_SA(0, 0), a2, voffA);
            PG8_BAR; PG8_WAIT_L(0); PG8_MMA(1, 0, At, B0); PG8_BAR; PG8_SCHED;
            PG8_STAGE(PG8_SB(0, 1), b2 + hstep, voffB);
            PG8_WAIT_V(6); PG8_BAR; PG8_MMA(1, 1, At, B1); PG8_BAR;
            PG8_LDB(B0, 1, 0); PG8_SCHED; PG8_LDA(At, 1, 0); PG8_STAGE(PG8_SA(0, 1), a2 + hstep, voffA);
            PG8_WAIT_L(8); PG8_BAR; PG8_WAIT_L(0); PG8_MMA(0, 0, At, B0); PG8_BAR; PG8_SCHED;
            PG8_LDB(B1, 1, 1); PG8_STAGE(PG8_SB(1, 0), b3, voffB);
            PG8_BAR; PG8_WAIT_L(0); PG8_MMA(0, 1, At, B1); PG8_BAR;
            PG8_LDA(At, 1, 1); PG8_STAGE(PG8_SA(1, 0), a3, voffA);
            PG8_BAR; PG8_WAIT_L(0); PG8_MMA(1, 0, At, B0); PG8_BAR; PG8_SCHED;
            PG8_STAGE(PG8_SB(1, 1), b3 + hstep, voffB);
            PG8_WAIT_V(6); PG8_BAR; PG8_MMA(1, 1, At, B1); PG8_BAR;
            }
        }
        if constexpr (ALIGN_EPI) { if (wr == 0) PG8_BAR; }
        if constexpr (!Epi::AFTER_DRAIN) { E(acc, cur, wr, wc, fr, fq); S.done(cur); }
        if (!has_next) break;
#pragma unroll
        for (int a = 0; a < 2; ++a)
#pragma unroll
            for (int b = 0; b < 2; ++b)
#pragma unroll
                for (int m = 0; m < 4; ++m)
#pragma unroll
                    for (int n = 0; n < 2; ++n) acc[a][b][m][n] = (f32x4){0.f, 0.f, 0.f, 0.f};
        cur = nxt; cA = nA; cB = nB; ++ui;
        if constexpr (ALIGN_EPI) { if (wr == 1) PG8_BAR; }
    }
    PG8_WAIT_V(0);
    if constexpr (!ALIGN_EPI) { if (wr == 0) PG8_BAR; }
    PG8_BAR;
    if constexpr (Epi::AFTER_DRAIN) { E.fused(acc, cur, wr, wc, fr, fq, lds, wid, lane); S.done(cur); }
#undef PG8_SA
#undef PG8_SB
#undef PG8_STAGE
#undef PG8_LDA
#undef PG8_LDB
#undef PG8_MMA
#undef PG8_WAIT_V
#undef PG8_WAIT_L
#undef PG8_BAR
#undef PG8_SCHED
}
}

#define LAS __attribute__((address_space(3)))
typedef unsigned short bf16;
typedef unsigned v4u __attribute__((ext_vector_type(4)));
typedef unsigned v2u __attribute__((ext_vector_type(2)));
typedef float f32x4 __attribute__((ext_vector_type(4)));
typedef float f32x16 __attribute__((ext_vector_type(16)));
typedef short s16x4 __attribute__((ext_vector_type(4)));
typedef short s16x8 __attribute__((ext_vector_type(8)));
constexpr int NWAVES = 8, NTHR = 512;
constexpr int RING_BYTES = 131072, LDS_BYTES = 147456;
#define LDS_WAIT() asm volatile("s_waitcnt lgkmcnt(0)" ::: "memory")
__device__ __forceinline__ unsigned f2bf(float f) { unsigned u = __builtin_bit_cast(unsigned, f); return (u + 0x7fffu + ((u >> 16) & 1u)) >> 16; }
__device__ __forceinline__ unsigned pk2(float lo, float hi) { return f2bf(lo) | (f2bf(hi) << 16); }
__device__ __forceinline__ float bf2f(unsigned short h) { return __uint_as_float((unsigned)h << 16); }

#define XB_TMO      128
#define XB_XCNT(j)  (256  + 64 * (j))
#define XB_XSUB(j)  (1280 + 64 * (j))
#define XB_XGEN(j)  (2304 + 64 * (j))
#define XB_TOP      3328
#define XB_TOPGEN   3392
#define XCD_BAR_WORDS 3456
#define XB_SPIN_CAP (1u << 18)

__device__ __forceinline__ unsigned xb_ld(unsigned* p)              { return __hip_atomic_load(p, __ATOMIC_RELAXED, __HIP_MEMORY_SCOPE_AGENT); }
__device__ __forceinline__ unsigned xb_add(unsigned* p, unsigned v) { return __hip_atomic_fetch_add(p, v, __ATOMIC_RELAXED, __HIP_MEMORY_SCOPE_AGENT); }
__device__ __forceinline__ unsigned xb_xcc_id() { return (unsigned)__builtin_amdgcn_s_getreg((3 << 11) | 20) & 0xFu; }
#define XB_SPIN(cond, bar) do { unsigned _sp = 0; while (cond) { __builtin_amdgcn_s_sleep(1); \
    if ((++_sp & 255u) == 0u) { if (xb_ld(&(bar)[XB_TMO])) break; if (_sp > XB_SPIN_CAP) { atomicAdd(&(bar)[XB_TMO], 1u); break; } } } } while (0)

struct XcdBarrier {
    unsigned* bar; unsigned x;
    volatile LAS unsigned* st;
};

__device__ __forceinline__ XcdBarrier xcd_barrier_post(unsigned* bar, volatile LAS unsigned* st) {
    XcdBarrier b; b.bar = bar; b.x = xb_xcc_id(); b.st = st;
    if (threadIdx.x == 0) (void)xb_add(&bar[XB_XCNT(b.x)], 1u);
    return b;
}
__device__ __forceinline__ void xcd_barrier_complete(unsigned* bar, unsigned x, unsigned& nloc, unsigned& nx) {
    const unsigned G = gridDim.x * gridDim.y * gridDim.z;
    unsigned sum, cnt, mine, sp = 0u;
    for (;;) {
        sum = 0u; cnt = 0u; mine = 0u;
#pragma unroll
        for (unsigned j = 0; j < 16; ++j) { const unsigned c = xb_ld(&bar[XB_XCNT(j)]); sum += c; cnt += (c > 0u) ? 1u : 0u; mine = (j == x) ? c : mine; }
        if (sum == G) break;
        __builtin_amdgcn_s_sleep(1);
        if ((++sp & 255u) == 0u) { if (xb_ld(&bar[XB_TMO])) break; if (sp > XB_SPIN_CAP) { atomicAdd(&bar[XB_TMO], 1u); break; } }
    }
    nloc = mine > 0u ? mine : 1u; nx = cnt > 0u ? cnt : 1u;
}

__device__ __forceinline__ void xcd_barrier(const XcdBarrier& b) {
    asm volatile("s_waitcnt vmcnt(0)" ::: "memory");
    __syncthreads();
    if (threadIdx.x == 0) {
        unsigned* bar = b.bar;
        __builtin_amdgcn_s_waitcnt(0);
        unsigned nloc = b.st[0], nx = b.st[1];
        if (nloc == 0u) { xcd_barrier_complete(bar, b.x, nloc, nx); b.st[0] = nloc; b.st[1] = nx; }
        const unsigned old = xb_add(&bar[XB_XSUB(b.x)], 1u);
        const unsigned gen = old / nloc;
        if (old + 1u == (gen + 1u) * nloc) {
            __builtin_amdgcn_fence(__ATOMIC_RELEASE, "agent");
            asm volatile("s_waitcnt vmcnt(0)" ::: "memory");
            const unsigned og = xb_add(&bar[XB_TOP], 1u);
            const unsigned tg = og / nx;
            if (og + 1u == (tg + 1u) * nx) xb_add(&bar[XB_TOPGEN], 1u);
            else XB_SPIN(xb_ld(&bar[XB_TOPGEN]) == tg, bar);
            __builtin_amdgcn_fence(__ATOMIC_ACQUIRE, "agent");
            xb_add(&bar[XB_XGEN(b.x)], 1u);
            asm volatile("s_waitcnt vmcnt(0)" ::: "memory");
        } else {
            XB_SPIN(xb_ld(&bar[XB_XGEN(b.x)]) == gen, bar);
            __builtin_amdgcn_fence(__ATOMIC_ACQUIRE, "agent");
            asm volatile("s_waitcnt vmcnt(0)" ::: "memory");
        }
    }
    __syncthreads();
}

struct Frame { LAS unsigned char* lds; int tid, lane, wave, G, vcu; unsigned char* ws; };

__device__ __forceinline__ int rope_rowmap(int n) {
    if (n < 4096 || n >= 5376) return n;
    const int d = n & 63, nn = d >> 5, w = (d >> 4) & 1, fq = (d >> 2) & 3, j = d & 3;
    return (n & ~63) + 32 * w + 8 * fq + 4 * nn + j;
}
__device__ __forceinline__ void transpose_item(const float* W, int N, bf16* WT, int ldd, int koff, bool rmap, LAS float* scr, int item, int lane) {
    const int nblk = N / 32, kb = item / nblk, nb = item % nblk, k0 = 64 * kb, n0 = 32 * nb;
#pragma unroll 8
    for (int i = 0; i < 32; ++i) { const int kk = 2 * i + (lane >> 5); scr[kk * 33 + (lane & 31)] = W[(size_t)(k0 + kk) * N + n0 + (lane & 31)]; }
    LDS_WAIT(); asm volatile("" ::: "memory");
    const int c = lane & 7;
#pragma unroll
    for (int j = 0; j < 4; ++j) { const int n = (lane >> 3) + 8 * j; const LAS float* s = scr + (8 * c) * 33 + n;
        v4u o; o.x = pk2(s[0 * 33], s[1 * 33]); o.y = pk2(s[2 * 33], s[3 * 33]); o.z = pk2(s[4 * 33], s[5 * 33]); o.w = pk2(s[6 * 33], s[7 * 33]);
        const int drow = rmap ? rope_rowmap(n0 + n) : (n0 + n);
        *(v4u*)(WT + (size_t)drow * ldd + koff + k0 + 8 * c) = o; }
    LDS_WAIT(); asm volatile("" ::: "memory");
}
__device__ __forceinline__ void transpose_weight(Frame& F, const float* W, int K, int N, bf16* WT, int ldd, int koff, bool rmap) {
    LAS float* scr = (LAS float*)(F.lds + F.wave * 16384);
    const int gw = F.vcu * NWAVES + F.wave, NGW = F.G * NWAVES, nitems = (K / 64) * (N / 32);
    for (int it = gw; it < nitems; it += NGW) transpose_item(W, N, WT, ldd, koff, rmap, scr, it, F.lane);
}
__device__ __forceinline__ float wave_sum(float v) {
#pragma unroll
    for (int o = 1; o < 64; o <<= 1) v += __shfl_xor(v, o);
    return v;
}
__device__ __forceinline__ void ln_phase(Frame& F, float* io, const float* gain, const float* bias, bf16* xb) {
    const int gw = F.vcu * NWAVES + F.wave, NGW = F.G * NWAVES;
    for (int r = gw; r < SEQ; r += NGW) {
        f32x4* p = (f32x4*)(io + (size_t)r * DM) + F.lane;
        f32x4 v[8]; float s = 0.f;
#pragma unroll
        for (int j = 0; j < 8; ++j) { v[j] = p[64 * j]; s += (v[j].x + v[j].y) + (v[j].z + v[j].w); }
        const float mean = wave_sum(s) * (1.f / DM); float s2 = 0.f;
#pragma unroll
        for (int j = 0; j < 8; ++j) { v[j] = v[j] - mean; s2 += (v[j].x * v[j].x + v[j].y * v[j].y) + (v[j].z * v[j].z + v[j].w * v[j].w); }
        const float rstd = 1.f / sqrtf(wave_sum(s2) * (1.f / DM) + 1e-5f);
#pragma unroll
        for (int j = 0; j < 8; ++j) { const f32x4 g = ((const f32x4*)gain)[64 * j + F.lane], b = ((const f32x4*)bias)[64 * j + F.lane];
            const f32x4 o = v[j] * rstd * g + b; p[64 * j] = o;
            if (xb) { v2u w; w.x = pk2(o.x, o.y); w.y = pk2(o.z, o.w); ((v2u*)(xb + (size_t)r * DM))[64 * j + F.lane] = w; } }
    }
}

constexpr int HL_QT = 0, HL_KT = 17408, HL_KH = 34816, HL_DV = 51200, HL_VT = 53248, HL_OS = 70656, HL_RED = 104448;
template <bool OUT> __device__ __forceinline__ void hgrn_unit(Frame& F, int u, const float* gain) {
    const int j = u >> 3, h = u & 7, tid = F.tid, lane = F.lane, w = F.wave, I = tid >> 7, k = tid & 127, dvl = lane & 15, q4 = lane >> 4;
    const float* lf = (const float*)(F.ws + WS_LF); const bf16* qh = (const bf16*)(F.ws + WS_QH); const bf16* hv = (const bf16*)(F.ws + WS_HV); const bf16* gs = (const bf16*)(F.ws + WS_GS);
    bf16* oab = (bf16*)(F.ws + WS_OAB);
    LAS bf16* Qt = (LAS bf16*)(F.lds + HL_QT); LAS bf16* Kt = (LAS bf16*)(F.lds + HL_KT); LAS bf16* KH = (LAS bf16*)(F.lds + HL_KH);
    LAS float* DV = (LAS float*)(F.lds + HL_DV); LAS bf16* VT = (LAS bf16*)(F.lds + HL_VT); LAS float* OS = (LAS float*)(F.lds + HL_OS); LAS float* RED = (LAS float*)(F.lds + HL_RED);
    f32x4 S[8];
    if (OUT) { const f32x4* sp = (const f32x4*)(F.ws + WS_SINIT) + (size_t)u * 4096 + w * 512 + lane;
#pragma unroll
        for (int j8 = 0; j8 < 8; ++j8) S[j8] = sp[j8 * 64]; }
    else {
#pragma unroll
        for (int j8 = 0; j8 < 8; ++j8) S[j8] = (f32x4){0.f, 0.f, 0.f, 0.f}; }
    float btot = 0.f;
    for (int ms = 0; ms < 4; ++ms) {
        const int t0 = 256 * j + 64 * ms;
        {
            const float* lfp = lf + (size_t)(t0 + 16 * I) * 1024 + h * 128 + k;
            float lv[16], b[16], kk[16];
#pragma unroll
            for (int i = 0; i < 16; ++i) lv[i] = lfp[(size_t)i * 1024];
            float qv[16];
            if (OUT) { const bf16* qp = qh + (size_t)(t0 + 16 * I) * 1024 + h * 128 + k;
#pragma unroll
                for (int i = 0; i < 16; ++i) qv[i] = bf2f(qp[(size_t)i * 1024]); }
            float run = 0.f;
#pragma unroll
            for (int i = 0; i < 16; ++i) { kk[i] = 1.0f - __expf(lv[i]); run += lv[i]; b[i] = run; }
            btot += run;
            unsigned pw[8];
#pragma unroll
            for (int i = 0; i < 8; ++i) pw[i] = pk2(kk[2 * i] * __expf(run - b[2 * i]), kk[2 * i + 1] * __expf(run - b[2 * i + 1]));
            LAS v4u* khp = (LAS v4u*)(KH + (I * 128 + k) * 16);
            khp[0] = (v4u){pw[0], pw[1], pw[2], pw[3]}; khp[1] = (v4u){pw[4], pw[5], pw[6], pw[7]};
            DV[I * 128 + k] = __expf(run);
            if (OUT) {
#pragma unroll
                for (int i = 0; i < 16; ++i) { Qt[(16 * I + i) * 136 + k] = (bf16)f2bf(qv[i] * __expf(b[i])); Kt[(16 * I + i) * 136 + k] = (bf16)f2bf(kk[i] * __expf(fminf(-b[i], 80.f))); } }
#pragma unroll
            for (int c = 0; c < 2; ++c) { const int ch = tid + 512 * c, tok = ch >> 4, dv0 = (ch & 15) * 8;
                const v4u vv = *(const v4u*)(hv + (size_t)(t0 + tok) * 1024 + h * 128 + dv0);
                VT[(dv0 + 0) * 68 + tok] = (bf16)(vv.x & 0xffffu); VT[(dv0 + 1) * 68 + tok] = (bf16)(vv.x >> 16);
                VT[(dv0 + 2) * 68 + tok] = (bf16)(vv.y & 0xffffu); VT[(dv0 + 3) * 68 + tok] = (bf16)(vv.y >> 16);
                VT[(dv0 + 4) * 68 + tok] = (bf16)(vv.z & 0xffffu); VT[(dv0 + 5) * 68 + tok] = (bf16)(vv.z >> 16);
                VT[(dv0 + 6) * 68 + tok] = (bf16)(vv.w & 0xffffu); VT[(dv0 + 7) * 68 + tok] = (bf16)(vv.w >> 16); }
        }
        __syncthreads();
#pragma unroll 1
        for (int I2 = 0; I2 < 4; ++I2) {
            const s16x4 vfrag = *(const LAS s16x4*)(VT + (16 * w + dvl) * 68 + 16 * I2 + 4 * q4);
            if (OUT) {
                f32x4 o = (f32x4){0.f, 0.f, 0.f, 0.f};
#pragma unroll
                for (int j8 = 0; j8 < 8; ++j8) { const s16x4 qf = *(const LAS s16x4*)(Qt + (16 * I2 + dvl) * 136 + 16 * j8 + 4 * q4);
                    v2u sw; sw.x = pk2(S[j8][0], S[j8][1]); sw.y = pk2(S[j8][2], S[j8][3]);
                    o = __builtin_amdgcn_mfma_f32_16x16x16bf16_1k(qf, __builtin_bit_cast(s16x4, sw), o, 0, 0, 0); }
                f32x4 sc = (f32x4){0.f, 0.f, 0.f, 0.f};
#pragma unroll
                for (int jj = 0; jj < 4; ++jj) { const s16x8 kf = *(const LAS s16x8*)(Kt + (16 * I2 + dvl) * 136 + 32 * jj + 8 * q4), qf8 = *(const LAS s16x8*)(Qt + (16 * I2 + dvl) * 136 + 32 * jj + 8 * q4);
                    sc = __builtin_amdgcn_mfma_f32_16x16x32_bf16(kf, qf8, sc, 0, 0, 0); }
#pragma unroll
                for (int r = 0; r < 4; ++r) if (4 * q4 + r > dvl) sc[r] = 0.f;
                v2u pwv; pwv.x = pk2(sc[0], sc[1]); pwv.y = pk2(sc[2], sc[3]);
                o = __builtin_amdgcn_mfma_f32_16x16x16bf16_1k(__builtin_bit_cast(s16x4, pwv), vfrag, o, 0, 0, 0);
#pragma unroll
                for (int r = 0; r < 4; ++r) OS[(16 * I2 + 4 * q4 + r) * 132 + 16 * w + dvl] = o[r];
            }
#pragma unroll
            for (int j8 = 0; j8 < 8; ++j8) { const f32x4 dsc = *(const LAS f32x4*)(DV + I2 * 128 + 16 * j8 + 4 * q4);
                const s16x4 af = *(const LAS s16x4*)(KH + (I2 * 128 + 16 * j8 + dvl) * 16 + 4 * q4);
                S[j8] = __builtin_amdgcn_mfma_f32_16x16x16bf16_1k(af, vfrag, S[j8] * dsc, 0, 0, 0); }
        }
        __syncthreads();
        if (OUT) {
            const int t = tid >> 3, seg = tid & 7; float ov[16]; float ss = 0.f;
#pragma unroll
            for (int e = 0; e < 16; e += 4) { const f32x4 x4 = *(const LAS f32x4*)(OS + t * 132 + 16 * seg + e); ov[e] = x4.x; ov[e + 1] = x4.y; ov[e + 2] = x4.z; ov[e + 3] = x4.w; ss += (x4.x * x4.x + x4.y * x4.y) + (x4.z * x4.z + x4.w * x4.w); }
            ss += __shfl_xor(ss, 1); ss += __shfl_xor(ss, 2); ss += __shfl_xor(ss, 4);
            const float rsn = 1.0f / sqrtf(ss * (1.0f / 128.0f) + 1e-6f);
            const int cg0 = h * 128 + 16 * seg;
            const v4u g0 = *(const v4u*)(gs + (size_t)(t0 + t) * 1024 + cg0), g1 = *(const v4u*)(gs + (size_t)(t0 + t) * 1024 + cg0 + 8);
            const unsigned gw[8] = {g0.x, g0.y, g0.z, g0.w, g1.x, g1.y, g1.z, g1.w};
            unsigned ow[8];
#pragma unroll
            for (int e = 0; e < 8; ++e) { const float a = ov[2 * e] * rsn * gain[cg0 + 2 * e] * __uint_as_float(gw[e] << 16), bb = ov[2 * e + 1] * rsn * gain[cg0 + 2 * e + 1] * __uint_as_float(gw[e] & 0xffff0000u); ow[e] = pk2(a, bb); }
            v4u* op = (v4u*)(oab + (size_t)(t0 + t) * 2048 + cg0);
            op[0] = (v4u){ow[0], ow[1], ow[2], ow[3]}; op[1] = (v4u){ow[4], ow[5], ow[6], ow[7]};
        }
    }
    if (!OUT) {
        f32x4* lp = (f32x4*)(F.ws + WS_L) + (size_t)u * 4096 + w * 512 + lane;
#pragma unroll
        for (int j8 = 0; j8 < 8; ++j8) lp[j8 * 64] = S[j8];
        RED[I * 128 + k] = btot;
        __syncthreads();
        if (tid < 128) ((float*)(F.ws + WS_DTOT))[u * 128 + tid] = __expf((RED[tid] + RED[128 + tid]) + (RED[256 + tid] + RED[384 + tid]));
        __syncthreads();
    }
}
__device__ __forceinline__ void hgrn_scan(Frame& F) {
    const int idx = F.vcu * NTHR + F.tid; if (idx >= 8 * 4096) return;
    const int h = idx >> 12, e = idx & 4095, ln = e & 63, j8 = (e >> 6) & 7, dk0 = 16 * j8 + 4 * (ln >> 4);
    const f32x4* L = (const f32x4*)(F.ws + WS_L); f32x4* SI = (f32x4*)(F.ws + WS_SINIT); const float* DT = (const float*)(F.ws + WS_DTOT);
    f32x4 S = (f32x4){0.f, 0.f, 0.f, 0.f};
#pragma unroll 1
    for (int jb = 0; jb < 32; jb += 8) {
        f32x4 l[8], d[8];
#pragma unroll
        for (int i = 0; i < 8; ++i) { const int u = (jb + i) * 8 + h; l[i] = L[(size_t)u * 4096 + e]; d[i] = *(const f32x4*)(DT + u * 128 + dk0); }
#pragma unroll
        for (int i = 0; i < 8; ++i) { const int u = (jb + i) * 8 + h; SI[(size_t)u * 4096 + e] = S; S = S * d[i] + l[i]; }
    }
}

constexpr int AL_K = 0, AL_VT = 36864, AL_L = 36864 + 33792;
__device__ __forceinline__ int crow(int r, int hi) { return (r & 3) + 8 * (r >> 2) + 4 * hi; }
__device__ __forceinline__ void attn_unit(Frame& F, int u, const float* sinks) {
    const int n = u >> 2, kvh = u & 3, tid = F.tid, lane = F.lane, w = F.wave, r32 = lane & 31, hi = lane >> 5;
    const bf16* aq = (const bf16*)(F.ws + WS_AQ); const bf16* ak = (const bf16*)(F.ws + WS_AK); const bf16* av = (const bf16*)(F.ws + WS_AV); bf16* oab = (bf16*)(F.ws + WS_OAB);
    LAS bf16* Ks = (LAS bf16*)(F.lds + AL_K); LAS bf16* VT = (LAS bf16*)(F.lds + AL_VT); LAS float* LW = (LAS float*)(F.lds + AL_L) + w * 32;
    __syncthreads();
#pragma unroll
    for (int c = 0; c < 4; ++c) { const int ch = tid + 512 * c, s = ch >> 3, d0 = (ch & 7) * 8; const int tok = 128 * (n - 1) + s;
        v4u kv = (v4u){0u, 0u, 0u, 0u}, vv = (v4u){0u, 0u, 0u, 0u};
        if (tok >= 0) { kv = *(const v4u*)(ak + (size_t)tok * 256 + kvh * 64 + d0); vv = *(const v4u*)(av + (size_t)tok * 256 + kvh * 64 + d0); }
        *(LAS v4u*)(Ks + s * 72 + d0) = kv;
        VT[(d0 + 0) * 264 + s] = (bf16)(vv.x & 0xffffu); VT[(d0 + 1) * 264 + s] = (bf16)(vv.x >> 16);
        VT[(d0 + 2) * 264 + s] = (bf16)(vv.y & 0xffffu); VT[(d0 + 3) * 264 + s] = (bf16)(vv.y >> 16);
        VT[(d0 + 4) * 264 + s] = (bf16)(vv.z & 0xffffu); VT[(d0 + 5) * 264 + s] = (bf16)(vv.z >> 16);
        VT[(d0 + 6) * 264 + s] = (bf16)(vv.w & 0xffffu); VT[(d0 + 7) * 264 + s] = (bf16)(vv.w >> 16); }
    __syncthreads();
    const int g = w >> 1, hq = kvh * 4 + g; const float sink2 = sinks[hq] * LOG2E;
#pragma unroll 1
    for (int sb = 0; sb < 2; ++sb) {
        const int q0 = (w & 1) * 64 + 32 * sb, a = q0 >> 5;
        s16x8 qr[4];
#pragma unroll
        for (int d0 = 0; d0 < 4; ++d0) qr[d0] = *(const s16x8*)(aq + (size_t)(128 * n + q0 + r32) * 1024 + hq * 64 + 16 * d0 + 8 * hi);
        f32x16 sc[5];
#pragma unroll
        for (int kt = 0; kt < 5; ++kt) { sc[kt] = (f32x16){};
#pragma unroll
            for (int d0 = 0; d0 < 4; ++d0) { const s16x8 kf = *(const LAS s16x8*)(Ks + (32 * (a + kt) + r32) * 72 + 16 * d0 + 8 * hi);
                sc[kt] = __builtin_amdgcn_mfma_f32_32x32x16_bf16(kf, qr[d0], sc[kt], 0, 0, 0); } }
        const int qi = q0 + r32; float mx = sink2;
#pragma unroll
        for (int kt = 0; kt < 5; ++kt)
#pragma unroll
            for (int r = 0; r < 16; ++r) { const int s = 32 * (a + kt) + crow(r, hi); const bool ok = (s > qi) && (s <= qi + 128) && (n > 0 || s >= 128);
                sc[kt][r] = ok ? sc[kt][r] : -INFINITY; mx = fmaxf(mx, sc[kt][r]); }
        mx = fmaxf(mx, __shfl_xor(mx, 32));
        float l = 0.f;
#pragma unroll
        for (int kt = 0; kt < 5; ++kt)
#pragma unroll
            for (int r = 0; r < 16; ++r) { const float p = __builtin_amdgcn_exp2f(sc[kt][r] - mx); sc[kt][r] = p; l += p; }
        l += __shfl_xor(l, 32); l += __builtin_amdgcn_exp2f(sink2 - mx);
        if (hi == 0) LW[r32] = 1.0f / l;
        f32x16 o[2]; o[0] = (f32x16){}; o[1] = (f32x16){};
#pragma unroll
        for (int kt = 0; kt < 5; ++kt)
#pragma unroll
            for (int sl = 0; sl < 2; ++sl) {
                v4u pw; pw.x = pk2(sc[kt][8 * sl + 0], sc[kt][8 * sl + 1]); pw.y = pk2(sc[kt][8 * sl + 2], sc[kt][8 * sl + 3]); pw.z = pk2(sc[kt][8 * sl + 4], sc[kt][8 * sl + 5]); pw.w = pk2(sc[kt][8 * sl + 6], sc[kt][8 * sl + 7]);
                const s16x8 pf = __builtin_bit_cast(s16x8, pw); const int kb = 32 * (a + kt) + 16 * sl + 4 * hi;
#pragma unroll
                for (int dt = 0; dt < 2; ++dt) { const v2u v0 = *(const LAS v2u*)(VT + (32 * dt + r32) * 264 + kb), v1 = *(const LAS v2u*)(VT + (32 * dt + r32) * 264 + kb + 8);
                    const v4u vw = (v4u){v0.x, v0.y, v1.x, v1.y};
                    o[dt] = __builtin_amdgcn_mfma_f32_32x32x16_bf16(pf, __builtin_bit_cast(s16x8, vw), o[dt], 0, 0, 0); } }
        LDS_WAIT(); asm volatile("" ::: "memory");
        bf16* op = oab + (size_t)(128 * n + q0) * 2048 + 1024 + hq * 64 + r32;
#pragma unroll
        for (int r = 0; r < 16; ++r) { const int qq = crow(r, hi); const float li = LW[qq];
            op[(size_t)qq * 2048] = (bf16)f2bf(o[0][r] * li); op[(size_t)qq * 2048 + 32] = (bf16)f2bf(o[1][r] * li); }
        LDS_WAIT(); asm volatile("" ::: "memory");
    }
}

struct Args { const float* in[14]; float* out; unsigned char* ws; };
__global__ void __launch_bounds__(NTHR, 2) fwd_kernel(Args args) {
    extern __shared__ __attribute__((aligned(16))) unsigned char lds[];
    cg::grid_group grid = cg::this_grid();
    Frame F; F.lds = (LAS unsigned char*)lds; F.tid = threadIdx.x; F.lane = F.tid & 63; F.wave = __builtin_amdgcn_readfirstlane(F.tid >> 6);
    F.G = gridDim.x; { const int bx = blockIdx.x; F.vcu = (F.G % 8 == 0) ? (bx % 8) * (F.G / 8) + bx / 8 : bx; }
    F.ws = args.ws;
    volatile LAS unsigned* MISC = (volatile LAS unsigned*)(F.lds + RING_BYTES + 320);
    if (F.tid < 64) ((LAS unsigned*)(F.lds + RING_BYTES))[F.tid + 64] = 0u, ((LAS unsigned*)(F.lds + RING_BYTES))[F.tid] = 0u;
    unsigned* barw = (unsigned*)(args.ws + WS_CTL) + 4096;
    if (blockIdx.x == 0) for (int q = F.tid; q < XCD_BAR_WORDS; q += NTHR) __hip_atomic_store(barw + q, 0u, __ATOMIC_RELAXED, __HIP_MEMORY_SCOPE_AGENT);
    __syncthreads();
    const float* x = args.in[0]; const float* w_in = args.in[1]; const float* lbl = args.in[2]; const float* hgain = args.in[3]; const float* sinks = args.in[4];
    const float* w_a = args.in[5]; const float* w_b = args.in[6]; const float* w_out = args.in[7]; const float* ln1g = args.in[8]; const float* ln1b = args.in[9];
    const float* w_ff1 = args.in[10]; const float* w_ff2 = args.in[11]; const float* ln2g = args.in[12]; const float* ln2b = args.in[13];
    unsigned char* ws = args.ws; float* out = args.out;
    const int gtid = F.vcu * NTHR + F.tid, GT = F.G * NTHR;

    transpose_weight(F, w_in, DM, DIN, (bf16*)(ws + WS_WIN), DM, 0, true);
    for (size_t i = gtid; i < (size_t)SEQ * DM / 4; i += GT) { const f32x4 v = ((const f32x4*)x)[i]; v2u o; o.x = pk2(v.x, v.y); o.y = pk2(v.z, v.w); ((v2u*)(ws + WS_XB))[i] = o; }
    for (int i = gtid; i < SEQ * 32; i += GT) { const int pos = i >> 5, fi = i & 31; const float inv = exp2f(-(float)fi * (13.287712379549449f / 32.0f));
        const float ang = (float)pos * inv; double rv = (double)ang * 0.15915494309189535; rv -= floor(rv); const float rf = (float)rv;
        float* rp = (float*)(ws + WS_ROPE) + (size_t)pos * 64 + fi; rp[0] = __builtin_amdgcn_cosf(rf); rp[32] = __builtin_amdgcn_sinf(rf); }
    grid.sync();
    XcdBarrier bar = xcd_barrier_post(barw, MISC + 8);
    { pg8::Gemm g{(const pg8::bf16_t*)(ws + WS_XB), (const pg8::bf16_t*)(ws + WS_WIN), SEQ, DIN, DM}; pg8::StaticOrder S; S.init(SEQ, DIN, F.G, (int)blockIdx.x);
#ifndef SKIP_G0
      pg8::Epi E{0, ws, x, lbl, out}; pg8::gemm_phase<pg8::Epi, pg8::StaticOrder, true, true>(F.lds, g, S, E); }
#else
 }
#endif
    xcd_barrier(bar);
#ifndef SKIP_HA
    for (int u = blockIdx.x; u < 256; u += F.G) hgrn_unit<false>(F, u, hgain);
#endif
#ifndef SKIP_AT
    for (int u = blockIdx.x; u < 256; u += F.G) attn_unit(F, u, sinks);
#endif
    xcd_barrier(bar);
#ifndef SKIP_SC
    hgrn_scan(F);
#endif
    transpose_weight(F, w_a, 1024, DM, (bf16*)(ws + WS_WAB), 2048, 0, false);
    transpose_weight(F, w_b, 1024, DM, (bf16*)(ws + WS_WAB), 2048, 1024, false);
    transpose_weight(F, w_out, DM, DM, (bf16*)(ws + WS_WOUT), 2048, 0, false);
    xcd_barrier(bar);
#ifndef SKIP_HC
    for (int u = blockIdx.x; u < 256; u += F.G) hgrn_unit<true>(F, u, hgain);
#endif
    xcd_barrier(bar);
    { pg8::Gemm g{(const pg8::bf16_t*)(ws + WS_OAB), (const pg8::bf16_t*)(ws + WS_WAB), SEQ, DM, 2048}; pg8::StaticOrder S; S.init(SEQ, DM, F.G, (int)blockIdx.x);
#ifndef SKIP_G1
      pg8::Epi E{1, ws, x, lbl, out}; pg8::gemm_phase<pg8::Epi, pg8::StaticOrder, true, true>(F.lds, g, S, E); }
#else
 }
#endif
    xcd_barrier(bar);
    { pg8::Gemm g{(const pg8::bf16_t*)(ws + WS_MIX), (const pg8::bf16_t*)(ws + WS_WOUT), SEQ, DM, DM}; pg8::StaticOrder S; S.init(SEQ, DM, F.G, (int)blockIdx.x);
#ifndef SKIP_G2
      pg8::Epi E{2, ws, x, lbl, out}; pg8::gemm_phase<pg8::Epi, pg8::StaticOrder, true, true>(F.lds, g, S, E); }
#else
 }
#endif
    xcd_barrier(bar);
    ln_phase(F, out, ln1g, ln1b, (bf16*)(ws + WS_X1B));
    transpose_weight(F, w_ff1, DM, DFF, (bf16*)(ws + WS_W1), DM, 0, false);
    transpose_weight(F, w_ff2, DFF, DM, (bf16*)(ws + WS_W2), DFF, 0, false);
    xcd_barrier(bar);
    { pg8::Gemm g{(const pg8::bf16_t*)(ws + WS_X1B), (const pg8::bf16_t*)(ws + WS_W1), SEQ, DFF, DM}; pg8::StaticOrder S; S.init(SEQ, DFF, F.G, (int)blockIdx.x);
#ifndef SKIP_G3
      pg8::Epi E{3, ws, x, lbl, out}; pg8::gemm_phase<pg8::Epi, pg8::StaticOrder, true, true>(F.lds, g, S, E); }
#else
 }
#endif
    xcd_barrier(bar);
    { pg8::Gemm g{(const pg8::bf16_t*)(ws + WS_H1), (const pg8::bf16_t*)(ws + WS_W2), SEQ, DM, DFF}; pg8::StaticOrder S; S.init(SEQ, DM, F.G, (int)blockIdx.x);
#ifndef SKIP_G4
      pg8::Epi E{4, ws, x, lbl, out}; pg8::gemm_phase<pg8::Epi, pg8::StaticOrder, true, true>(F.lds, g, S, E); }
#else
 }
#endif
    xcd_barrier(bar);
    ln_phase(F, out, ln2g, ln2b, nullptr);
}

extern "C" void kernel_launch(void* const* d_in, const int* in_sizes, int n_in, void* d_out, int out_size, void* d_ws, size_t ws_size, hipStream_t stream) {
    static int grid = 0;
    if (grid == 0) {
        if (n_in != 14 || in_sizes[0] != SEQ * DM || out_size != SEQ * DM || ws_size < WS_END) { fprintf(stderr, "kernel_launch: unexpected shapes (n_in %d, ws %zu)\n", n_in, ws_size); grid = -1; return; }
        int dev = 0, cus = 0, per_cu = 0;
        hipGetDevice(&dev); hipDeviceGetAttribute(&cus, hipDeviceAttributeMultiprocessorCount, dev);
        if (hipFuncSetAttribute((const void*)fwd_kernel, hipFuncAttributeMaxDynamicSharedMemorySize, LDS_BYTES) != hipSuccess) { fprintf(stderr, "kernel_launch: hipFuncSetAttribute failed\n"); grid = -1; return; }
        if (hipOccupancyMaxActiveBlocksPerMultiprocessor(&per_cu, (const void*)fwd_kernel, NTHR, LDS_BYTES) != hipSuccess || per_cu < 1) { fprintf(stderr, "kernel_launch: occupancy query says %d\n", per_cu); per_cu = 1; }
        (void)hipGetLastError();
        grid = cus * (per_cu > 1 ? 1 : per_cu);
    }
    if (grid < 0) return;
    Args a{};
    for (int i = 0; i < 14; ++i) a.in[i] = (const float*)d_in[i];
    a.out = (float*)d_out; a.ws = (unsigned char*)d_ws;
    void* kargs[] = {&a};
    hipError_t e = hipLaunchCooperativeKernel((const void*)fwd_kernel, dim3(grid), dim3(NTHR), kargs, LDS_BYTES, stream);
    if (e != hipSuccess) fprintf(stderr, "kernel_launch: cooperative launch failed: %s (grid %d)\n", hipGetErrorString(e), grid);
}
```
